# Optimizing an MI355X kernel written in HIP

```python
import math
import jax, jax.numpy as jnp
from jax import lax
import numpy as np

D_MODEL = 2048
BATCH = 4
SEQ = 2048
DEPTH = 4
DEC_BATCH = 128
DEC_SEQ = 8
PAST_LEN = 16384
PAGE_SIZE = 128

D_MIX = D_MODEL
S5_WIDTH = D_MIX // 4
S5_GROUP = 16
S5_GROUPS = S5_WIDTH // S5_GROUP
S5_STATE = 64
RWKV_WIDTH = (3 * D_MIX) // 8
RWKV_HEAD = 64
RWKV_HEADS = RWKV_WIDTH // RWKV_HEAD
RWKV_DECAY_LORA = 64
RWKV_A_LORA = 64
RWKV_GATE_LORA = 128
RWKV_SHIFT_WIDTH = 3 * RWKV_WIDTH + RWKV_DECAY_LORA + RWKV_A_LORA + RWKV_GATE_LORA
RWKV_GN_EPS = 64e-5
HGRN_WIDTH = D_MIX - S5_WIDTH - RWKV_WIDTH
HGRN_EXPAND = 128
HGRN_HEADS = HGRN_WIDTH // HGRN_EXPAND
HGRN_HEAD_V = HGRN_WIDTH // HGRN_HEADS
HGRN_CHUNK = 64
HGRN_EPS = 1e-5
N_IN = S5_WIDTH + RWKV_SHIFT_WIDTH + 4 * HGRN_WIDTH
D_FF = ((8 * D_MODEL // 3 + 255) // 256) * 256
NORM_EPS = 1e-6

kernel_name = 'hybrid_s5_rwkv7_hgrn2_step'


def rms_norm(x, w, eps=NORM_EPS):
    x32 = x.astype(jnp.float32)
    y = x32 * lax.rsqrt(jnp.mean(x32 * x32, axis=-1, keepdims=True) + eps)
    return (y * w.astype(jnp.float32)).astype(x.dtype)


def swiglu_ffn(x, w_gate, w_up, w_down):
    return (jax.nn.silu(x @ w_gate) * (x @ w_up)) @ w_down


def s5_mixer(u, x0_re, x0_im, a_re, a_im, log_dt, b_re, b_im, c_re, c_im, d, w_glu, b_glu):
    n, t, _ = u.shape
    f32 = jnp.float32
    lam = lax.complex(a_re.astype(f32), a_im.astype(f32))
    dt = jnp.exp(log_dt.astype(f32))[:, None]
    a_bar = jnp.exp(lam * dt)
    b = lax.complex(b_re.astype(f32), b_im.astype(f32))
    b_bar = ((a_bar - 1.0) / lam)[..., None] * b
    c = lax.complex(c_re.astype(f32), c_im.astype(f32))
    u32 = u.astype(f32)
    ug = u32.reshape(n, t, S5_GROUPS, S5_GROUP).astype(jnp.complex64)
    bu = jnp.einsum('gph,ntgh->ntgp', b_bar, ug)
    x0 = lax.complex(x0_re.astype(f32), x0_im.astype(f32))
    bu = bu.at[:, 0].add(a_bar * x0)
    a_seq = jnp.broadcast_to(a_bar, bu.shape)

    def combine(e1, e2):
        a1, b1 = e1
        a2, b2 = e2
        return a2 * a1, a2 * b1 + b2

    _, xs = lax.associative_scan(combine, (a_seq, bu), axis=1)
    y = jnp.real(jnp.einsum('ghp,ntgp->ntgh', c, xs)).reshape(n, t, S5_WIDTH)
    y = jax.nn.gelu(y + d.astype(f32) * u32)
    out = y * jax.nn.sigmoid(y @ w_glu.astype(f32) + b_glu.astype(f32))
    x_last = xs[:, -1]
    return out, jnp.real(x_last), jnp.imag(x_last)


def rwkv7_mixer(z, shift0, s0, mu, w0, w2, a0, a2, g2, k_k, k_a, r_k, ln_w, ln_b):
    n, t, _ = z.shape
    f32 = jnp.float32
    z = z.astype(f32)
    prev = jnp.concatenate([shift0.astype(f32)[:, None], z[:, :-1]], axis=1)
    zm = z + (prev - z) * mu.astype(f32)
    o1 = 3 * RWKV_WIDTH
    o2 = o1 + RWKV_DECAY_LORA
    o3 = o2 + RWKV_A_LORA
    r = zm[..., :RWKV_WIDTH]
    k = zm[..., RWKV_WIDTH:2 * RWKV_WIDTH]
    v = zm[..., 2 * RWKV_WIDTH:o1]
    wi, ai, gi = zm[..., o1:o2], zm[..., o2:o3], zm[..., o3:]
    w = -jax.nn.softplus(-(w0 + jnp.tanh(wi) @ w2)) - 0.5
    decay = jnp.exp(-jnp.exp(w))
    a = jax.nn.sigmoid(a0 + ai @ a2)
    g = jax.nn.sigmoid(gi) @ g2

    def heads(y):
        return y.reshape(n, t, RWKV_HEADS, RWKV_HEAD)

    kk = heads(k * k_k)
    kk = kk * lax.rsqrt(jnp.maximum(jnp.sum(kk * kk, axis=-1, keepdims=True), 1e-24))
    k = k * (1.0 + (a - 1.0) * k_a)
    rh, kh, vh, dh, ah = heads(r), heads(k), heads(v), heads(decay), heads(a)
    bh = kk * ah

    def step(S, inp):
        r_t, k_t, v_t, d_t, kk_t, b_t = inp
        sa = jnp.einsum('nhvk,nhk->nhv', S, -kk_t)
        S = S * d_t[:, :, None, :] + sa[..., None] * b_t[:, :, None, :] + v_t[..., None] * k_t[:, :, None, :]
        return S, jnp.einsum('nhvk,nhk->nhv', S, r_t)

    seq = tuple(jnp.moveaxis(y_, 1, 0) for y_ in (rh, kh, vh, dh, kk, bh))
    s_last, ys = lax.scan(step, s0.astype(f32), seq)
    y = jnp.moveaxis(ys, 0, 1)
    mean = jnp.mean(y, axis=-1, keepdims=True)
    var = jnp.mean(jnp.square(y - mean), axis=-1, keepdims=True)
    y = ((y - mean) * lax.rsqrt(var + RWKV_GN_EPS)).reshape(n, t, RWKV_WIDTH) * ln_w + ln_b
    bonus = jnp.sum(rh * kh * r_k, axis=-1, keepdims=True) * vh
    y = (y + bonus.reshape(n, t, RWKV_WIDTH)) * g
    return y, z[:, -1], s_last


def hgrn2_mixer(q, f, i, g, s0, lb, norm_w):
    n, t, _ = q.shape
    f32 = jnp.float32

    def heads(y):
        return y.astype(f32).reshape(n, t, HGRN_HEADS, -1)

    fg = lb + (1.0 - lb) * jax.nn.sigmoid(f.astype(f32))
    qh = jax.nn.silu(heads(q))
    kh = heads(1.0 - fg)
    lfh = heads(jnp.log(fg))
    vh = heads(i)
    c = math.gcd(t, HGRN_CHUNK)
    nc = t // c

    def chunks(y):
        return jnp.transpose(y.reshape(n, nc, c, HGRN_HEADS, -1), (1, 0, 3, 2, 4))

    mask = jnp.tril(jnp.ones((c, c), bool))[:, :, None]

    def step(S, inp):
        q_c, k_c, v_c, lf_c = inp
        b = jnp.cumsum(lf_c, axis=2)
        o_inter = jnp.einsum('nhtk,nhkv->nhtv', q_c * jnp.exp(b), S)
        diff = b[:, :, :, None, :] - b[:, :, None, :, :]
        dec = jnp.where(mask, jnp.exp(jnp.where(mask, diff, 0.0)), 0.0)
        att = jnp.einsum('nhtk,nhtsk,nhsk->nhts', q_c, dec, k_c)
        o = o_inter + jnp.einsum('nhts,nhsv->nhtv', att, v_c)
        b_last = b[:, :, -1]
        S = jnp.exp(b_last)[..., None] * S + jnp.einsum('nhsk,nhsv->nhkv', k_c * jnp.exp(b_last[:, :, None] - b), v_c)
        return S, o

    s_last, os_ = lax.scan(step, s0.astype(f32), tuple(chunks(y) for y in (qh, kh, vh, lfh)))
    o = jnp.transpose(os_, (1, 0, 3, 2, 4)).reshape(n, t, HGRN_HEADS, HGRN_HEAD_V)
    o = o * lax.rsqrt(jnp.mean(o * o, axis=-1, keepdims=True) + HGRN_EPS)
    o = o.reshape(n, t, HGRN_WIDTH) * norm_w * jax.nn.silu(g.astype(f32))
    return o, s_last


def _normal(k, shape, scale):
    return jax.random.normal(k, shape, jnp.float32) * scale


def setup_inputs(seed: int = 0) -> dict:
    key = jax.random.key(seed)
    ks = iter(jax.random.split(key, 48))
    L = DEPTH
    G, P, H = S5_GROUPS, S5_STATE, S5_GROUP
    n_idx = jnp.arange(P, dtype=jnp.float32)
    inp = {}
    inp['x_prompt'] = _normal(next(ks), (BATCH, SEQ, D_MODEL), 1.0)
    inp['x_sample'] = _normal(next(ks), (DEC_BATCH, DEC_SEQ, D_MODEL), 1.0)
    inp['state_s5_re'] = _normal(next(ks), (L, DEC_BATCH, G, P), 0.5)
    inp['state_s5_im'] = _normal(next(ks), (L, DEC_BATCH, G, P), 0.5)
    inp['state_rwkv_shift'] = _normal(next(ks), (L, DEC_BATCH, RWKV_SHIFT_WIDTH), 1.0)
    inp['state_rwkv_wkv'] = _normal(next(ks), (L, DEC_BATCH, RWKV_HEADS, RWKV_HEAD, RWKV_HEAD), 1.0)
    inp['state_hgrn'] = _normal(next(ks), (L, DEC_BATCH, HGRN_HEADS, HGRN_EXPAND, HGRN_HEAD_V), 0.5)
    inp['norm_ffn1'] = 1.0 + _normal(next(ks), (L, D_MODEL), 0.02)
    inp['ffn1_w_gate'] = _normal(next(ks), (L, D_MODEL, D_FF), D_MODEL ** -0.5)
    inp['ffn1_w_up'] = _normal(next(ks), (L, D_MODEL, D_FF), D_MODEL ** -0.5)
    inp['ffn1_w_down'] = _normal(next(ks), (L, D_FF, D_MODEL), D_FF ** -0.5)
    inp['norm_mix'] = 1.0 + _normal(next(ks), (L, D_MODEL), 0.02)
    inp['w_in'] = _normal(next(ks), (L, D_MODEL, N_IN), D_MODEL ** -0.5)
    inp['s5_a_re'] = -0.5 + _normal(next(ks), (L, G, P), 0.01)
    inp['s5_a_im'] = math.pi * n_idx + _normal(next(ks), (L, G, P), 0.01)
    inp['s5_log_dt'] = jax.random.uniform(next(ks), (L, G), jnp.float32, math.log(1e-3), math.log(1e-1))
    inp['s5_b_re'] = _normal(next(ks), (L, G, P, H), (2.0 * H) ** -0.5)
    inp['s5_b_im'] = _normal(next(ks), (L, G, P, H), (2.0 * H) ** -0.5)
    inp['s5_c_re'] = _normal(next(ks), (L, G, H, P), (2.0 * P) ** -0.5)
    inp['s5_c_im'] = _normal(next(ks), (L, G, H, P), (2.0 * P) ** -0.5)
    inp['s5_d'] = _normal(next(ks), (L, S5_WIDTH), 1.0)
    inp['s5_w_glu'] = _normal(next(ks), (L, S5_WIDTH, S5_WIDTH), S5_WIDTH ** -0.5)
    inp['s5_b_glu'] = _normal(next(ks), (L, S5_WIDTH), 0.01)
    inp['rwkv_mu'] = jax.random.uniform(next(ks), (L, RWKV_SHIFT_WIDTH), jnp.float32, 0.0, 1.0)
    inp['rwkv_w0'] = jax.random.uniform(next(ks), (L, RWKV_WIDTH), jnp.float32, -6.0, 0.0)
    inp['rwkv_w2'] = _normal(next(ks), (L, RWKV_DECAY_LORA, RWKV_WIDTH), RWKV_DECAY_LORA ** -0.5)
    inp['rwkv_a0'] = _normal(next(ks), (L, RWKV_WIDTH), 0.5)
    inp['rwkv_a2'] = _normal(next(ks), (L, RWKV_A_LORA, RWKV_WIDTH), RWKV_A_LORA ** -0.5)
    inp['rwkv_g2'] = _normal(next(ks), (L, RWKV_GATE_LORA, RWKV_WIDTH), RWKV_GATE_LORA ** -0.5)
    inp['rwkv_k_k'] = 0.85 + _normal(next(ks), (L, RWKV_WIDTH), 0.05)
    inp['rwkv_k_a'] = 1.0 + _normal(next(ks), (L, RWKV_WIDTH), 0.05)
    inp['rwkv_r_k'] = _normal(next(ks), (L, RWKV_HEADS, RWKV_HEAD), 0.1)
    inp['rwkv_ln_w'] = 1.0 + _normal(next(ks), (L, RWKV_WIDTH), 0.02)
    inp['rwkv_ln_b'] = _normal(next(ks), (L, RWKV_WIDTH), 0.01)
    inp['hgrn_lb_raw'] = _normal(next(ks), (L, HGRN_WIDTH), 0.1)
    inp['hgrn_norm_w'] = 1.0 + _normal(next(ks), (L, HGRN_WIDTH), 0.02)
    inp['w_out'] = _normal(next(ks), (L, D_MIX, D_MODEL), D_MIX ** -0.5)
    inp['norm_ffn2'] = 1.0 + _normal(next(ks), (L, D_MODEL), 0.02)
    inp['ffn2_w_gate'] = _normal(next(ks), (L, D_MODEL, D_FF), D_MODEL ** -0.5)
    inp['ffn2_w_up'] = _normal(next(ks), (L, D_MODEL, D_FF), D_MODEL ** -0.5)
    inp['ffn2_w_down'] = _normal(next(ks), (L, D_FF, D_MODEL), D_FF ** -0.5)
    inp['norm_final'] = 1.0 + _normal(next(ks), (D_MODEL,), 0.02)
    return inp


def reference(x_prompt, x_sample, state_s5_re, state_s5_im, state_rwkv_shift, state_rwkv_wkv, state_hgrn,
              norm_ffn1, ffn1_w_gate, ffn1_w_up, ffn1_w_down, norm_mix, w_in,
              s5_a_re, s5_a_im, s5_log_dt, s5_b_re, s5_b_im, s5_c_re, s5_c_im, s5_d, s5_w_glu, s5_b_glu,
              rwkv_mu, rwkv_w0, rwkv_w2, rwkv_a0, rwkv_a2, rwkv_g2, rwkv_k_k, rwkv_k_a, rwkv_r_k,
              rwkv_ln_w, rwkv_ln_b, hgrn_lb_raw, hgrn_norm_w, w_out,
              norm_ffn2, ffn2_w_gate, ffn2_w_up, ffn2_w_down, norm_final):
    p_lb = jax.nn.softmax(hgrn_lb_raw.astype(jnp.float32), axis=0)
    lower_bounds = jnp.cumsum(p_lb, axis=0) - p_lb[0]
    o_rw = S5_WIDTH
    o_hg = S5_WIDTH + RWKV_SHIFT_WIDTH

    def run(x, s5_re0, s5_im0, shift0, wkv0, hgrn0):
        s5_re_l, s5_im_l, shift_l, wkv_l, hgrn_l = [], [], [], [], []
        for l in range(DEPTH):
            h = rms_norm(x, norm_ffn1[l])
            x = x + 0.5 * swiglu_ffn(h, ffn1_w_gate[l], ffn1_w_up[l], ffn1_w_down[l])
            h = rms_norm(x, norm_mix[l])
            p = h @ w_in[l]
            y_s5, s_re, s_im = s5_mixer(p[..., :o_rw], s5_re0[l], s5_im0[l], s5_a_re[l], s5_a_im[l],
                                        s5_log_dt[l], s5_b_re[l], s5_b_im[l], s5_c_re[l], s5_c_im[l],
                                        s5_d[l], s5_w_glu[l], s5_b_glu[l])
            y_rw, sh, wkv = rwkv7_mixer(p[..., o_rw:o_hg], shift0[l], wkv0[l], rwkv_mu[l], rwkv_w0[l],
                                        rwkv_w2[l], rwkv_a0[l], rwkv_a2[l], rwkv_g2[l], rwkv_k_k[l],
                                        rwkv_k_a[l], rwkv_r_k[l], rwkv_ln_w[l], rwkv_ln_b[l])
            hq = p[..., o_hg:o_hg + HGRN_WIDTH]
            hf = p[..., o_hg + HGRN_WIDTH:o_hg + 2 * HGRN_WIDTH]
            hi = p[..., o_hg + 2 * HGRN_WIDTH:o_hg + 3 * HGRN_WIDTH]
            hgt = p[..., o_hg + 3 * HGRN_WIDTH:]
            y_hg, hs = hgrn2_mixer(hq, hf, hi, hgt, hgrn0[l], lower_bounds[l], hgrn_norm_w[l])
            mix = jnp.concatenate([y_s5, y_rw, y_hg], axis=-1).astype(x.dtype)
            x = x + mix @ w_out[l]
            h = rms_norm(x, norm_ffn2[l])
            x = x + 0.5 * swiglu_ffn(h, ffn2_w_gate[l], ffn2_w_up[l], ffn2_w_down[l])
            s5_re_l.append(s_re)
            s5_im_l.append(s_im)
            shift_l.append(sh)
            wkv_l.append(wkv)
            hgrn_l.append(hs)
        y = rms_norm(x, norm_final)
        return y, jnp.stack(s5_re_l), jnp.stack(s5_im_l), jnp.stack(shift_l), jnp.stack(wkv_l), jnp.stack(hgrn_l)

    nb = x_prompt.shape[0]

    def zeros_like_state(s):
        return jnp.zeros((DEPTH, nb) + s.shape[2:], jnp.float32)

    y_p, s5re_p, s5im_p, shift_p, wkv_p, hgrn_p = run(
        x_prompt, zeros_like_state(state_s5_re), zeros_like_state(state_s5_im),
        zeros_like_state(state_rwkv_shift), zeros_like_state(state_rwkv_wkv), zeros_like_state(state_hgrn))
    y_s, s5re_s, s5im_s, shift_s, wkv_s, hgrn_s = run(
        x_sample, state_s5_re, state_s5_im, state_rwkv_shift, state_rwkv_wkv, state_hgrn)
    return (y_p, y_s, s5re_p, s5im_p, shift_p, wkv_p, hgrn_p, s5re_s, s5im_s, shift_s, wkv_s, hgrn_s)
```

```cpp
#include <hip/hip_runtime.h>
#include <cstdio>
#include <cstdint>

#ifndef MK_PER_PHASE
#define MK_PER_PHASE 0
#define MK_REP 0
#define MK_NANFILL 0
#ifndef MK_QSKIP
#define MK_QSKIP 0
#endif
#endif
namespace pg8 {
#define PG8_LAS __attribute__((address_space(3)))
typedef unsigned short bf16_t;
typedef short bf16x8 __attribute__((ext_vector_type(8)));
typedef float f32x4 __attribute__((ext_vector_type(4)));
typedef unsigned u32x4 __attribute__((ext_vector_type(4)));
constexpr int BM = 256, BK = 64, HALF = 128, HTB = HALF * BK * 2  , STAGE_BYTES = 8 * HTB, NXCD = 8, WGM = 6;

__host__ __device__ __forceinline__ int lds_byte(int r, int c) { const int st = (r >> 4) * 2 + (c >> 5), rr = r & 15, cc = c & 31, ob = rr * 64 + cc * 2; return st * 1024 + (ob ^ (((ob >> 9) & 1) << 5)); }
__host__ __device__ __forceinline__ void stage_rc(int b, int& R, int& C) { const int st = b / 1024, sb = b % 1024, swz = sb ^ (((sb >> 9) & 1) << 5); R = (st >> 1) * 16 + swz / 64; C = (st & 1) * 32 + (swz % 64) / 2; }
__host__ __device__ __forceinline__ int perm32(int rho) { const int n = rho >> 4, i = rho & 15; return 8 * (i >> 2) + 4 * n + (i & 3); }

struct Unit { int pm, pn; int kt0, nkt, part, nparts, slot; };
struct Gemm { const bf16_t* A; const bf16_t* Bt; int M, N, K; };

struct StaticOrder {
    int nM, nN, nwg, G, c, nktf;
    __host__ __device__ void init(int M, int N, int K, int G_, int c_) { nM = M / BM; nN = N / BM; nwg = nM * nN; G = G_; c = c_; nktf = K / BK; }
    __host__ __device__ void tile_of(int L, Unit& u) const {
        int wgid = L; { const int q = nwg / NXCD, r = nwg % NXCD, xcd = wgid % NXCD, off = wgid / NXCD; wgid = (xcd < r ? xcd * (q + 1) : r * (q + 1) + (xcd - r) * q) + off; }
        const int nig = WGM * nN, gid = wgid / nig, fm = gid * WGM, gsz = (nM - fm) < WGM ? (nM - fm) : WGM;
        u.pm = fm + ((wgid % nig) % gsz); u.pn = (wgid % nig) / gsz; }
    __host__ __device__ bool next(int i, Unit& u) const {
        const long L = (long)i * G + c; if (L >= nwg) return false;
        tile_of((int)L, u); u.kt0 = 0; u.nkt = nktf; u.part = -1; u.nparts = 1; u.slot = 0; return true;
    }
    __device__ __forceinline__ void a_ready(const Unit&) const {}
    __device__ __forceinline__ void done(const Unit&) const {}
};
struct SplitOrder : StaticOrder {
    __host__ __device__ bool unit_of(int i, Unit& u, int kmax) const {
        const int rounds = nwg / G, r = nwg % G; u.kt0 = 0; u.nkt = nktf; u.part = -1; u.nparts = 1; u.slot = 0; u.pm = 0; u.pn = 0;
        if (i < rounds) { tile_of(i * G + c, u); return true; }
        if (i > rounds || r == 0) return false;
        int k = G / r; const int ntg = nktf / 4; if (k > ntg) k = ntg; if (k > kmax) k = kmax;
        if (c >= r * k) return false;
        const int U = c / k, j = c % k, g0 = (j * ntg) / k, g1 = ((j + 1) * ntg) / k;
        tile_of(rounds * G + U, u); u.kt0 = 4 * g0; u.nkt = 4 * (g1 - g0); u.part = (k > 1) ? j : -1; u.nparts = k; u.slot = U * k; return true;
    }
};
typedef __bf16 bf16x2_t __attribute__((ext_vector_type(2)));
typedef float f32x2_t __attribute__((ext_vector_type(2)));
__device__ __forceinline__ unsigned cvt_pk_bf16(float lo, float hi) { const f32x2_t v = {lo, hi}; const bf16x2_t r = __builtin_convertvector(v, bf16x2_t); return __builtin_bit_cast(unsigned, r); }
struct TabOrder {
    const PG8_LAS int* tab;
    __device__ __forceinline__ bool next(int i, Unit& u) const {
        if (i >= 16 || __builtin_amdgcn_readfirstlane(tab[8 * i + 7]) == 0) return false;
        u.pm = __builtin_amdgcn_readfirstlane(tab[8 * i]); u.pn = __builtin_amdgcn_readfirstlane(tab[8 * i + 1]); u.kt0 = __builtin_amdgcn_readfirstlane(tab[8 * i + 2]); u.nkt = __builtin_amdgcn_readfirstlane(tab[8 * i + 3]);
        u.part = __builtin_amdgcn_readfirstlane(tab[8 * i + 4]); u.nparts = __builtin_amdgcn_readfirstlane(tab[8 * i + 5]); u.slot = __builtin_amdgcn_readfirstlane(tab[8 * i + 6]); return true;
    }
    __device__ __forceinline__ void a_ready(const Unit&) const {}
    __device__ __forceinline__ void done(const Unit&) const {}
};
__device__ __forceinline__ TabOrder fill_unit_table(int M, int N, int K, int G, int c, int kmax  , PG8_LAS int* tabw, int tid) {
    if (tid < 16) { SplitOrder S; S.init(M, N, K, G, c); Unit u; bool ok;
        if (kmax > 1) ok = S.unit_of(tid, u, kmax); else ok = S.next(tid, u);
        tabw[8 * tid] = u.pm; tabw[8 * tid + 1] = u.pn; tabw[8 * tid + 2] = u.kt0; tabw[8 * tid + 3] = u.nkt; tabw[8 * tid + 4] = u.part; tabw[8 * tid + 5] = u.nparts; tabw[8 * tid + 6] = (ok && u.part < 0) ? tid : u.slot;        tabw[8 * tid + 7] = ok ? 1 : 0; }
    __syncthreads();
    TabOrder T; T.tab = tabw; return T;
}
struct SplitCtx { float* slots; unsigned* cnt; unsigned* tmo; };
template <class Epi, class Sched, bool ALIGN_EPI = false, bool SP2 = false>
__device__ __forceinline__ void gemm_phase(PG8_LAS unsigned char* lds, const Gemm g, const Sched& S, const Epi& E, const SplitCtx sk = SplitCtx{nullptr, nullptr, nullptr}) {
    int tid_ = threadIdx.x; asm volatile("" : "+v"(tid_));
    const int tid = tid_, wid = __builtin_amdgcn_readfirstlane(tid >> 6), lane = tid & 63, wr = wid >> 2, wc = wid & 3, fr = lane & 15, fq = lane >> 4;
    const int K = g.K;
    unsigned voffA[2], voffB[2];
#pragma unroll
    for (int i = 0; i < 2; ++i) { int R, C; stage_rc(tid * 16 + i * 8192, R, C); const int Rb = Epi::PERM ? ((R & ~31) + perm32(R & 31)) : R;
        voffA[i] = (unsigned)(R * K + C) * 2u; voffB[i] = (unsigned)(Rb * K + C) * 2u; }
    const size_t kstep = (size_t)(BK * 2);
    const size_t hstep = (size_t)HALF * K * 2;
    const size_t tstep = 2 * hstep;
    const unsigned ldsw = (unsigned)wid * 1024u;
    const int aoff = lds_byte(wr * 64 + fr, fq * 8), boff = lds_byte(wc * 32 + fr, fq * 8);
#define PG8_SA(b, h) (((b) * 2 + (h)) * HTB)
#define PG8_SB(b, h) ((4 + (b) * 2 + (h)) * HTB)
#define PG8_STAGE(bufoff, gbase, voff) do { _Pragma("unroll") for (int _i = 0; _i < 2; ++_i) \
        __builtin_amdgcn_global_load_lds((const unsigned*)((const char*)(gbase) + (voff)[_i]), (PG8_LAS unsigned*)(lds + (bufoff) + ldsw + _i * 8192), 16, 0, 0); } while (0)
#define PG8_LDA(dst, b, h) do { _Pragma("unroll") for (int m = 0; m < 4; ++m) _Pragma("unroll") for (int k = 0; k < 2; ++k) dst[m][k] = *(const PG8_LAS bf16x8*)(lds + PG8_SA(b, h) + aoff + m * 2048 + k * 1024); } while (0)
#define PG8_LDB(dst, b, h) do { _Pragma("unroll") for (int n = 0; n < 2; ++n) _Pragma("unroll") for (int k = 0; k < 2; ++k) dst[n][k] = *(const PG8_LAS bf16x8*)(lds + PG8_SB(b, h) + boff + n * 2048 + k * 1024); } while (0)
#define PG8_MMA(ai, bj, At, Bt) do { __builtin_amdgcn_s_setprio(1); _Pragma("unroll") for (int m = 0; m < 4; ++m) _Pragma("unroll") for (int n = 0; n < 2; ++n) _Pragma("unroll") for (int k = 0; k < 2; ++k) \
        acc[ai][bj][m][n] = __builtin_amdgcn_mfma_f32_16x16x32_bf16(Bt[n][k], At[m][k], acc[ai][bj][m][n], 0, 0, 0); __builtin_amdgcn_s_setprio(0); } while (0)
#define PG8_WAIT_V(n) asm volatile("s_waitcnt vmcnt(" #n ")" ::: "memory")
#define PG8_WAIT_L(n) asm volatile("s_waitcnt lgkmcnt(" #n ")" ::: "memory")
#define PG8_BAR __builtin_amdgcn_s_barrier()
#define PG8_SCHED __builtin_amdgcn_sched_barrier(0)
    Unit cur, nxt; int ui = 0;
    if (!S.next(0, cur)) return;
    f32x4 acc[2][2][4][2];
#pragma unroll
    for (int a = 0; a < 2; ++a)
#pragma unroll
        for (int b = 0; b < 2; ++b)
#pragma unroll
            for (int m = 0; m < 4; ++m)
#pragma unroll
                for (int n = 0; n < 2; ++n) acc[a][b][m][n] = (f32x4){0.f, 0.f, 0.f, 0.f};
    bf16x8 At[4][2], B0[2][2], B1[2][2];
    const char* cA = (const char*)g.A + (size_t)cur.pm * tstep + (size_t)cur.kt0 * kstep; const char* cB = (const char*)g.Bt + (size_t)cur.pn * tstep + (size_t)cur.kt0 * kstep;
    S.a_ready(cur);
    if constexpr (SP2) {
        PG8_STAGE(PG8_SB(0, 0), cB, voffB); PG8_STAGE(PG8_SB(0, 1), cB + hstep, voffB); PG8_STAGE(PG8_SA(0, 0), cA, voffA); PG8_STAGE(PG8_SA(0, 1), cA + hstep, voffA);
        if (wr == 1) PG8_BAR;
        PG8_WAIT_V(2); PG8_BAR;
        PG8_STAGE(PG8_SB(1, 0), cB + kstep, voffB); PG8_STAGE(PG8_SA(1, 0), cA + kstep, voffA); PG8_STAGE(PG8_SB(1, 1), cB + hstep + kstep, voffB);
        PG8_WAIT_V(6); PG8_BAR;
    } else {
        PG8_STAGE(PG8_SB(0, 0), cB, voffB); PG8_STAGE(PG8_SA(0, 0), cA, voffA); PG8_STAGE(PG8_SB(0, 1), cB + hstep, voffB); PG8_STAGE(PG8_SA(0, 1), cA + hstep, voffA);
        if (wr == 1) PG8_BAR;
        PG8_WAIT_V(4); PG8_BAR;
        PG8_STAGE(PG8_SB(1, 0), cB + kstep, voffB); PG8_STAGE(PG8_SA(1, 0), cA + kstep, voffA); PG8_STAGE(PG8_SB(1, 1), cB + hstep + kstep, voffB);
        PG8_WAIT_V(6); PG8_BAR;
    }
    for (;;) {
        const bool has_next = S.next(ui + 1, nxt);
        const char* nA = has_next ? (const char*)g.A + (size_t)nxt.pm * tstep + (size_t)nxt.kt0 * kstep : cA; const char* nB = has_next ? (const char*)g.Bt + (size_t)nxt.pn * tstep + (size_t)nxt.kt0 * kstep : cB;
        const int nt = cur.nkt;
        for (int t = 0; t < nt; t += 2) {
            const bool last = (t == nt - 2);
            const char* a1 = cA + (size_t)(t + 1) * kstep;
            const char* a2 = last ? nA : cA + (size_t)(t + 2) * kstep; const char* b2 = last ? nB : cB + (size_t)(t + 2) * kstep;
            const char* a3 = a2 + kstep; const char* b3 = b2 + kstep;
            if (last && has_next) S.a_ready(nxt);
            if constexpr (SP2) {
            PG8_LDB(B0, 0, 0); PG8_LDB(B1, 0, 1); PG8_SCHED; PG8_LDA(At, 0, 0); PG8_STAGE(PG8_SA(1, 1), a1 + hstep, voffA);
            PG8_WAIT_V(8); PG8_WAIT_L(0); PG8_BAR; PG8_MMA(0, 0, At, B0); PG8_MMA(0, 1, At, B1); PG8_BAR; PG8_SCHED;
            PG8_LDA(At, 0, 1); PG8_STAGE(PG8_SB(0, 0), b2, voffB); PG8_STAGE(PG8_SB(0, 1), b2 + hstep, voffB); PG8_STAGE(PG8_SA(0, 0), a2, voffA);
            PG8_WAIT_V(8); PG8_WAIT_L(0); PG8_BAR; PG8_MMA(1, 0, At, B0); PG8_MMA(1, 1, At, B1); PG8_BAR; PG8_SCHED;
            PG8_LDB(B0, 1, 0); PG8_LDB(B1, 1, 1); PG8_SCHED; PG8_LDA(At, 1, 0); PG8_STAGE(PG8_SA(0, 1), a2 + hstep, voffA);
            PG8_WAIT_V(8); PG8_WAIT_L(0); PG8_BAR; PG8_MMA(0, 0, At, B0); PG8_MMA(0, 1, At, B1); PG8_BAR; PG8_SCHED;
            PG8_LDA(At, 1, 1); PG8_STAGE(PG8_SB(1, 0), b3, voffB); PG8_STAGE(PG8_SB(1, 1), b3 + hstep, voffB); PG8_STAGE(PG8_SA(1, 0), a3, voffA);
            PG8_WAIT_V(8); PG8_WAIT_L(0); PG8_BAR; PG8_MMA(1, 0, At, B0); PG8_MMA(1, 1, At, B1); PG8_BAR; PG8_SCHED;
            } else {
            PG8_LDB(B0, 0, 0); PG8_SCHED; PG8_LDA(At, 0, 0); PG8_STAGE(PG8_SA(1, 1), a1 + hstep, voffA);
            PG8_WAIT_L(8); PG8_BAR; PG8_WAIT_L(0); PG8_MMA(0, 0, At, B0); PG8_BAR; PG8_SCHED;
            PG8_LDB(B1, 0, 1); PG8_STAGE(PG8_SB(0, 0), b2, voffB);
            PG8_BAR; PG8_WAIT_L(0); PG8_MMA(0, 1, At, B1); PG8_BAR;
            PG8_LDA(At, 0, 1); PG8_STAGE(PG8_SA(0, 0), a2, voffA);
            PG8_BAR; PG8_WAIT_L(0); PG8_MMA(1, 0, At, B0); PG8_BAR; PG8_SCHED;
            PG8_STAGE(PG8_SB(0, 1), b2 + hstep, voffB);
            PG8_WAIT_V(6); PG8_BAR; PG8_MMA(1, 1, At, B1); PG8_BAR;
            PG8_LDB(B0, 1, 0); PG8_SCHED; PG8_LDA(At, 1, 0); PG8_STAGE(PG8_SA(0, 1), a2 + hstep, voffA);
            PG8_WAIT_L(8); PG8_BAR; PG8_WAIT_L(0); PG8_MMA(0, 0, At, B0); PG8_BAR; PG8_SCHED;
            PG8_LDB(B1, 1, 1); PG8_STAGE(PG8_SB(1, 0), b3, voffB);
            PG8_BAR; PG8_WAIT_L(0); PG8_MMA(0, 1, At, B1); PG8_BAR;
            PG8_LDA(At, 1, 1); PG8_STAGE(PG8_SA(1, 0), a3, voffA);
            PG8_BAR; PG8_WAIT_L(0); PG8_MMA(1, 0, At, B0); PG8_BAR; PG8_SCHED;
            PG8_STAGE(PG8_SB(1, 1), b3 + hstep, voffB);
            PG8_WAIT_V(6); PG8_BAR; PG8_MMA(1, 1, At, B1); PG8_BAR;
            }
        }
        if constexpr (ALIGN_EPI) { if (wr == 0) PG8_BAR; }
        if constexpr (!Epi::AFTER_DRAIN) { if (cur.part < 0) { E(acc, cur, wr, wc, fr, fq); S.done(cur); } }
        if (!has_next) break;
#pragma unroll
        for (int a = 0; a < 2; ++a)
#pragma unroll
            for (int b = 0; b < 2; ++b)
#pragma unroll
                for (int m = 0; m < 4; ++m)
#pragma unroll
                    for (int n = 0; n < 2; ++n) acc[a][b][m][n] = (f32x4){0.f, 0.f, 0.f, 0.f};
        cur = nxt; cA = nA; cB = nB; ++ui;
        if constexpr (ALIGN_EPI) { if (wr == 1) PG8_BAR; }
    }
    PG8_WAIT_V(0);
    if constexpr (!ALIGN_EPI) { if (wr == 0) PG8_BAR; }
    PG8_BAR;
    if constexpr (!Epi::AFTER_DRAIN) { if (cur.part >= 0) {
        float* myslot = sk.slots + (size_t)(cur.slot + cur.part) * 65536;
        const __amdgpu_buffer_rsrc_t rs = __builtin_amdgcn_make_buffer_rsrc(myslot, 0, 131072, 0x00020000);
#pragma unroll
        for (int ai = 0; ai < 2; ++ai)
#pragma unroll
            for (int bj = 0; bj < 2; ++bj)
#pragma unroll
                for (int m = 0; m < 4; ++m) { const f32x4 a0 = acc[ai][bj][m][0], a1 = acc[ai][bj][m][1];
                    u32x4 w; w.x = cvt_pk_bf16(a0[0], a0[1]); w.y = cvt_pk_bf16(a0[2], a0[3]); w.z = cvt_pk_bf16(a1[0], a1[1]); w.w = cvt_pk_bf16(a1[2], a1[3]);
                    __builtin_amdgcn_raw_buffer_store_b128(w, rs, ((((ai * 2 + bj) * 4 + m)) * 512 + tid) * 16, 0, 16); }
        asm volatile("s_waitcnt vmcnt(0)" ::: "memory");
        __syncthreads();
        unsigned* cw = sk.cnt + 16 * (cur.slot / cur.nparts);
        if (tid == 0) {
            __hip_atomic_fetch_add(cw, 1u, __ATOMIC_RELAXED, __HIP_MEMORY_SCOPE_AGENT);
            unsigned sp = 0;
            while (__hip_atomic_load(cw, __ATOMIC_RELAXED, __HIP_MEMORY_SCOPE_AGENT) < (unsigned)cur.nparts) { __builtin_amdgcn_s_sleep(2);
                if ((++sp & 1023u) == 0u) { if (__hip_atomic_load(sk.tmo, __ATOMIC_RELAXED, __HIP_MEMORY_SCOPE_AGENT)) break; if (sp > (1u << 24)) { __hip_atomic_store(sk.tmo, 1u, __ATOMIC_RELAXED, __HIP_MEMORY_SCOPE_AGENT); break; } } }
            __builtin_amdgcn_fence(__ATOMIC_ACQUIRE, "agent");
            asm volatile("s_waitcnt vmcnt(0)" ::: "memory");
        }
        __syncthreads();
        const int g0 = (8 * cur.part) / cur.nparts, g1 = (8 * (cur.part + 1)) / cur.nparts;
        for (int gq = g0; gq < g1; ++gq) { const int ai = gq >> 2, m = gq & 3;
            f32x4 v[2][2] = {{{0.f, 0.f, 0.f, 0.f}, {0.f, 0.f, 0.f, 0.f}}, {{0.f, 0.f, 0.f, 0.f}, {0.f, 0.f, 0.f, 0.f}}};
#pragma unroll
            for (int ph = 0; ph < 2; ++ph) { if (4 * ph < cur.nparts) {
                u32x4 pw[4][2];
#pragma unroll
                for (int pp = 0; pp < 4; ++pp)
#pragma unroll
                    for (int bj = 0; bj < 2; ++bj) { const int p = 4 * ph + pp; pw[pp][bj] = (u32x4){0u, 0u, 0u, 0u};
                        if (p < cur.nparts) pw[pp][bj] = *(const u32x4*)((const char*)(sk.slots + (size_t)(cur.slot + p) * 65536) + (size_t)(((ai * 2 + bj) * 4 + m) * 512 + tid) * 16); }
#pragma unroll
                for (int pp = 0; pp < 4; ++pp)
#pragma unroll
                    for (int bj = 0; bj < 2; ++bj) { const u32x4 w = pw[pp][bj];
                        v[bj][0] += (f32x4){__uint_as_float(w.x << 16), __uint_as_float(w.x & 0xffff0000u), __uint_as_float(w.y << 16), __uint_as_float(w.y & 0xffff0000u)};
                        v[bj][1] += (f32x4){__uint_as_float(w.z << 16), __uint_as_float(w.z & 0xffff0000u), __uint_as_float(w.w << 16), __uint_as_float(w.w & 0xffff0000u)}; } } }
            E.group(v, cur, ai, m, wr, wc, fr, fq); }
    } }
    if constexpr (Epi::AFTER_DRAIN) { E.fused(acc, cur, wr, wc, fr, fq, lds, wid, lane); S.done(cur); }
#undef PG8_SA
#undef PG8_SB
#undef PG8_STAGE
#undef PG8_LDA
#undef PG8_LDB
#undef PG8_MMA
#undef PG8_WAIT_V
#undef PG8_WAIT_L
#undef PG8_BAR
#undef PG8_SCHED
}
}
#define XB_TMO      128
#define XB_XCNT(j)  (256  + 64 * (j))
#define XB_XSUB(j)  (1280 + 64 * (j))
#define XB_XGEN(j)  (2304 + 64 * (j))
#define XB_TOP      3328
#define XB_TOPGEN   3392
#define XCD_BAR_WORDS 3456
#define XB_SPIN_CAP (1u << 24)
#define LAS __attribute__((address_space(3)))

__device__ __forceinline__ unsigned xb_ld(unsigned* p)              { return __hip_atomic_load(p, __ATOMIC_RELAXED, __HIP_MEMORY_SCOPE_AGENT); }
__device__ __forceinline__ unsigned xb_add(unsigned* p, unsigned v) { return __hip_atomic_fetch_add(p, v, __ATOMIC_RELAXED, __HIP_MEMORY_SCOPE_AGENT); }
__device__ __forceinline__ unsigned xb_xcc_id() { return (unsigned)__builtin_amdgcn_s_getreg((3 << 11) | 20) & 0xFu; }
#define XB_SPIN(cond, bar) do { unsigned _sp = 0; while (cond) { __builtin_amdgcn_s_sleep(1); \
    if ((++_sp & 255u) == 0u) { if (xb_ld(&(bar)[XB_TMO])) break; if (_sp > XB_SPIN_CAP) { atomicAdd(&(bar)[XB_TMO], 1u); break; } } } } while (0)

struct XcdBarrier {
    unsigned* bar; unsigned x;
    volatile LAS unsigned* st;
};

__device__ __forceinline__ XcdBarrier xcd_barrier_post(unsigned* bar, volatile LAS unsigned* st) {
    XcdBarrier b; b.bar = bar; b.x = xb_xcc_id(); b.st = st;
    if (threadIdx.x == 0) (void)xb_add(&bar[XB_XCNT(b.x)], 1u);
    return b;
}
__device__ __forceinline__ void xcd_barrier_complete(unsigned* bar, unsigned x, unsigned& nloc, unsigned& nx) {
    const unsigned G = gridDim.x * gridDim.y * gridDim.z;
    unsigned sum, cnt, mine, sp = 0u;
    for (;;) {
        sum = 0u; cnt = 0u; mine = 0u;
#pragma unroll
        for (unsigned j = 0; j < 16; ++j) { const unsigned c = xb_ld(&bar[XB_XCNT(j)]); sum += c; cnt += (c > 0u) ? 1u : 0u; mine = (j == x) ? c : mine; }
        if (sum == G) break;
        __builtin_amdgcn_s_sleep(1);
        if ((++sp & 255u) == 0u) { if (xb_ld(&bar[XB_TMO])) break; if (sp > XB_SPIN_CAP) { atomicAdd(&bar[XB_TMO], 1u); break; } }
    }
    nloc = mine > 0u ? mine : 1u; nx = cnt > 0u ? cnt : 1u;
}

__device__ __forceinline__ void xcd_barrier(const XcdBarrier& b) {
    asm volatile("s_waitcnt vmcnt(0)" ::: "memory");
    __syncthreads();
    if (threadIdx.x == 0) {
        unsigned* bar = b.bar;
        __builtin_amdgcn_s_waitcnt(0);
        unsigned nloc = b.st[0], nx = b.st[1];
        if (nloc == 0u) { xcd_barrier_complete(bar, b.x, nloc, nx); b.st[0] = nloc; b.st[1] = nx; }
        const unsigned old = xb_add(&bar[XB_XSUB(b.x)], 1u);
        const unsigned gen = old / nloc;
        if (old + 1u == (gen + 1u) * nloc) {
            __builtin_amdgcn_fence(__ATOMIC_RELEASE, "agent");
            asm volatile("s_waitcnt vmcnt(0)" ::: "memory");
            const unsigned og = xb_add(&bar[XB_TOP], 1u);
            const unsigned tg = og / nx;
            if (og + 1u == (tg + 1u) * nx) xb_add(&bar[XB_TOPGEN], 1u);
            else XB_SPIN(xb_ld(&bar[XB_TOPGEN]) == tg, bar);
            __builtin_amdgcn_fence(__ATOMIC_ACQUIRE, "agent");
            xb_add(&bar[XB_XGEN(b.x)], 1u);
            asm volatile("s_waitcnt vmcnt(0)" ::: "memory");
        } else {
            XB_SPIN(xb_ld(&bar[XB_XGEN(b.x)]) == gen, bar);
            __builtin_amdgcn_fence(__ATOMIC_ACQUIRE, "agent");
            asm volatile("s_waitcnt vmcnt(0)" ::: "memory");
        }
    }
    __syncthreads();
}


namespace mk {
using pg8::bf16_t; using pg8::bf16x8; using pg8::f32x4; using pg8::u32x4; using pg8::cvt_pk_bf16;
#define MK_LDS __attribute__((address_space(3)))
typedef unsigned u32x2 __attribute__((ext_vector_type(2)));

constexpr int D = 2048, NTOK = 9216, NPR = 8192, DFF = 5632, NGU = 11264, NIN = 6144, NL = 4;
constexpr int TP = 2048, BS = 128, TS = 8;
constexpr int O_RW = 512, O_HG = 3072, RSW = 2560;
constexpr float NORM_EPS = 1e-6f;

enum { I_XP = 0, I_XS, I_S5RE, I_S5IM, I_SHIFT, I_WKV, I_HGRN, I_NORM1, I_G1, I_U1, I_D1, I_NORMM, I_WIN, I_AARE, I_AAIM, I_LOGDT, I_BRE, I_BIM, I_CRE, I_CIM, I_S5D, I_WGLU, I_BGLU,
       I_MU, I_W0, I_W2, I_A0, I_A2, I_G2, I_KK, I_KA, I_RK, I_LNW, I_LNB, I_LBRAW, I_HNW, I_WOUT, I_NORM2, I_G2F, I_U2F, I_D2F, I_NORMF, N_IN };
constexpr size_t O_YP = 0, O_YS = 16777216, O_S5RE_P = 18874368, O_S5IM_P = 18907136, O_SHIFT_P = 18939904, O_WKV_P = 18980864, O_HGRN_P = 19767296,
                 O_S5RE_S = 21340160, O_S5IM_S = 22388736, O_SHIFT_S = 23437312, O_WKV_S = 24748032, O_HGRN_S = 49913856, O_END = 100245504;
constexpr size_t WS_CTL = 0, CTL_BYTES = 65536;
constexpr size_t WS_X = WS_CTL + CTL_BYTES;
constexpr size_t WS_HB = WS_X + (size_t)NTOK * D * 4;
constexpr size_t WS_H = WS_HB + (size_t)NTOK * D * 2;
constexpr size_t WS_P = WS_H + (size_t)NTOK * DFF * 2;
constexpr size_t WS_RW = WS_P + (size_t)NTOK * NIN * 4;
constexpr size_t WS_HGC = WS_RW;
constexpr size_t WS_YRW = WS_RW + (size_t)NTOK * 12 * 448 * 4;
constexpr size_t WS_OHG = WS_YRW + (size_t)NTOK * 768 * 4;
constexpr size_t WS_YS5 = WS_OHG + (size_t)NTOK * 768 * 4;
constexpr size_t WS_YS5B = WS_YS5 + (size_t)NTOK * 512 * 4;
constexpr size_t WS_MIX = WS_YS5B + (size_t)NTOK * 512 * 2;
constexpr size_t WS_S5E = WS_MIX + (size_t)NTOK * D * 2;
constexpr size_t WS_BONUS = WS_S5E + (size_t)4 * 32 * 32 * 128 * 4;
constexpr size_t WS_RWC = (WS_BONUS + (size_t)NTOK * 12 * 4 + 255) & ~(size_t)255;
constexpr size_t WS_W = WS_RWC + (size_t)1536 * 98816;
constexpr size_t W_GU1 = 0, W_DN1 = W_GU1 + (size_t)NGU * D * 2, W_WIN = W_DN1 + (size_t)D * DFF * 2, W_GLU = W_WIN + (size_t)NIN * D * 2, W_WOUT = W_GLU + 512 * 512 * 2,
                 W_GU2 = W_WOUT + (size_t)D * D * 2, W_DN2 = W_GU2 + (size_t)NGU * D * 2, W_LORA = W_DN2 + (size_t)D * DFF * 2, W_LAYER = W_LORA + 768 * 256 * 2;
constexpr size_t WS_SK = WS_W + 4 * W_LAYER;
constexpr size_t WS_SKC = WS_SK + (size_t)2 * 256 * 262144;
constexpr size_t SKC_BYTES = (size_t)48 * 96 * 64;
constexpr size_t WS_END = WS_SKC + SKC_BYTES;
constexpr int CW_BAR = 0, CW_Q = 4096, CW_CONV = 8192;
constexpr int MISC_OFF = 150528, LDS_BYTES = 150528 + 3072;

struct Args { const float* in[N_IN]; float* out; unsigned char* ws; int ph_lo, ph_hi; };

__device__ __forceinline__ const float* inp(const Args& a, int i) { asm volatile("" : "+s"(i)); return a.in[i]; }
__device__ __forceinline__ int otid() { int t = threadIdx.x; asm volatile("" : "+v"(t)); return t; }
__device__ __forceinline__ float wave_sum(float x) {
#pragma unroll
    for (int o = 32; o > 0; o >>= 1) x += __shfl_xor(x, o);
    return x;
}
template <int CTRL> __device__ __forceinline__ float dpp_f(float x) { return __builtin_bit_cast(float, __builtin_amdgcn_update_dpp(0, __builtin_bit_cast(int, x), CTRL, 0xF, 0xF, true)); }
__device__ __forceinline__ float row16_sum(float x) { x += dpp_f<0xB1>(x); x += dpp_f<0x4E>(x); x += dpp_f<0x141>(x); x += dpp_f<0x140>(x); return x; }
__device__ __forceinline__ float sigmoid_f(float x) { return __builtin_amdgcn_rcpf(1.0f + __expf(-x)); }
__device__ __forceinline__ float silu_f(float x) { return x * sigmoid_f(x); }
__device__ __forceinline__ float tanh_f(float x) { return 1.0f - 2.0f * __builtin_amdgcn_rcpf(__expf(2.0f * x) + 1.0f); }
__device__ __forceinline__ float gelu_tanh_f(float x) { return 0.5f * x * (1.0f + tanh_f(0.7978845608028654f * (x + 0.044715f * x * x * x))); }
__device__ __forceinline__ unsigned short bf16_1(float x) { return (unsigned short)(cvt_pk_bf16(x, 0.f) & 0xffffu); }

struct EpiSwiGLU {
    static constexpr bool PERM = false, AFTER_DRAIN = false;
    bf16_t* H; const float* rstd; const MK_LDS float* rs;
    __device__ __forceinline__ void emit(const f32x4 (&v)[2][2], float r, int row, int col0) const {
        float h[8];
#pragma unroll
        for (int n = 0; n < 2; ++n)
#pragma unroll
            for (int i = 0; i < 4; ++i) h[4 * n + i] = silu_f(v[0][n][i] * r) * (v[1][n][i] * r);
        u32x4 w; w.x = cvt_pk_bf16(h[0], h[1]); w.y = cvt_pk_bf16(h[2], h[3]); w.z = cvt_pk_bf16(h[4], h[5]); w.w = cvt_pk_bf16(h[6], h[7]);
        *(u32x4*)(H + (size_t)row * DFF + col0) = w;
    }
    __device__ __forceinline__ void group(const f32x4 (&v)[2][2], const pg8::Unit& u, int ai, int m, int wr, int wc, int fr, int fq) const {
        const int row = u.pm * 256 + wr * 64 + fr + ai * 128 + m * 16, col0 = u.pn * 128 + wc * 32 + 8 * fq;
        emit(v, rstd[row], row, col0);
    }
    __device__ __forceinline__ void operator()(const f32x4 (&acc)[2][2][4][2], const pg8::Unit& u, int wr, int wc, int fr, int fq) const {
        const int row0 = u.pm * 256 + wr * 64 + fr, col0 = u.pn * 128 + wc * 32 + 8 * fq;
        float rr[2][4];
#pragma unroll
        for (int ai = 0; ai < 2; ++ai)
#pragma unroll
            for (int m = 0; m < 4; ++m) rr[ai][m] = rs[u.slot * 256 + wr * 64 + fr + ai * 128 + m * 16];
#pragma unroll
        for (int ai = 0; ai < 2; ++ai)
#pragma unroll
            for (int m = 0; m < 4; ++m) { const f32x4 v[2][2] = {{acc[ai][0][m][0], acc[ai][0][m][1]}, {acc[ai][1][m][0], acc[ai][1][m][1]}}; emit(v, rr[ai][m], row0 + ai * 128 + m * 16, col0); }
    }
};
struct EpiResid {
    static constexpr bool PERM = false, AFTER_DRAIN = false;
    bf16_t* X; float s;
    static __device__ __forceinline__ f32x4 up4(unsigned x, unsigned y) { return (f32x4){__uint_as_float(x << 16), __uint_as_float(x & 0xffff0000u), __uint_as_float(y << 16), __uint_as_float(y & 0xffff0000u)}; }
    static __device__ __forceinline__ void rmw(bf16_t* p, const f32x4 a0, const f32x4 a1, const u32x4 xw, float s) {
        unsigned ax = xw.x, ay = xw.y, bx = xw.z, by = xw.w;
        { const auto t = __builtin_amdgcn_permlane16_swap(ax, bx, false, false); ax = t[0]; bx = t[1]; }
        { const auto t = __builtin_amdgcn_permlane16_swap(ay, by, false, false); ay = t[0]; by = t[1]; }
        const f32x4 v0 = up4(ax, ay) + a0 * s, v1 = up4(bx, by) + a1 * s;
        ax = cvt_pk_bf16(v0[0], v0[1]); ay = cvt_pk_bf16(v0[2], v0[3]); bx = cvt_pk_bf16(v1[0], v1[1]); by = cvt_pk_bf16(v1[2], v1[3]);
        { const auto t = __builtin_amdgcn_permlane16_swap(ax, bx, false, false); ax = t[0]; bx = t[1]; }
        { const auto t = __builtin_amdgcn_permlane16_swap(ay, by, false, false); ay = t[0]; by = t[1]; }
        *(u32x4*)p = (u32x4){ax, ay, bx, by};
    }
    __device__ __forceinline__ void group(const f32x4 (&v)[2][2], const pg8::Unit& u, int ai, int m, int wr, int wc, int fr, int fq) const {
        bf16_t* rowp = X + (size_t)(u.pm * 256 + wr * 64 + fr + ai * 128 + m * 16) * D + u.pn * 256 + wc * 32 + (fq & 1) * 16 + (fq >> 1) * 8;
        u32x4 xw[2];
#pragma unroll
        for (int bj = 0; bj < 2; ++bj) xw[bj] = *(const u32x4*)(rowp + bj * 128);
#pragma unroll
        for (int bj = 0; bj < 2; ++bj) rmw(rowp + bj * 128, v[bj][0], v[bj][1], xw[bj], s);
    }
    __device__ __forceinline__ void operator()(const f32x4 (&acc)[2][2][4][2], const pg8::Unit& u, int wr, int wc, int fr, int fq) const {
        bf16_t* base = X + (size_t)(u.pm * 256 + wr * 64 + fr) * D + u.pn * 256 + wc * 32 + (fq & 1) * 16 + (fq >> 1) * 8;
#pragma unroll
        for (int ai = 0; ai < 2; ++ai) {
            u32x4 xw[4][2];
#pragma unroll
            for (int m = 0; m < 4; ++m)
#pragma unroll
                for (int bj = 0; bj < 2; ++bj) xw[m][bj] = *(const u32x4*)(base + (size_t)(ai * 128 + m * 16) * D + bj * 128);
#pragma unroll
            for (int m = 0; m < 4; ++m)
#pragma unroll
                for (int bj = 0; bj < 2; ++bj) rmw(base + (size_t)(ai * 128 + m * 16) * D + bj * 128, acc[ai][bj][m][0], acc[ai][bj][m][1], xw[m][bj], s); }
    }
};
__device__ __forceinline__ float pbf(const bf16_t* p) { return __uint_as_float(((unsigned)*p) << 16); }
__device__ __forceinline__ f32x4 pbf4(const bf16_t* p) { const u32x2 w = *(const u32x2*)p; return (f32x4){__uint_as_float(w.x << 16), __uint_as_float(w.x & 0xffff0000u), __uint_as_float(w.y << 16), __uint_as_float(w.y & 0xffff0000u)}; }
struct EpiStoreP {
    static constexpr bool PERM = false, AFTER_DRAIN = false;
    float* C; int ldc; const float* rstd; const MK_LDS float* rs;
    __device__ __forceinline__ void emit(const f32x4 (&v)[2][2], float r, const pg8::Unit& u, size_t off) const {
        if (u.pm < NPR / 256) {
            const int fq_ = (int)((off >> 2) & 3);
            bf16_t* rowp = (bf16_t*)C + (off - 4 * fq_) + (fq_ & 1) * 16 + (fq_ >> 1) * 8;
#pragma unroll
            for (int bj = 0; bj < 2; ++bj) { const f32x4 t0 = v[bj][0] * r, t1 = v[bj][1] * r;
                unsigned ax = cvt_pk_bf16(t0[0], t0[1]), ay = cvt_pk_bf16(t0[2], t0[3]), bx = cvt_pk_bf16(t1[0], t1[1]), by = cvt_pk_bf16(t1[2], t1[3]);
                { const auto s = __builtin_amdgcn_permlane16_swap(ax, bx, false, false); ax = s[0]; bx = s[1]; }
                { const auto s = __builtin_amdgcn_permlane16_swap(ay, by, false, false); ay = s[0]; by = s[1]; }
                *(u32x4*)(rowp + bj * 128) = (u32x4){ax, ay, bx, by}; } }
        else { float* rowp = C + off;
#pragma unroll
            for (int bj = 0; bj < 2; ++bj)
#pragma unroll
                for (int n = 0; n < 2; ++n) *(f32x4*)(rowp + bj * 128 + n * 16) = v[bj][n] * r; }
    }
    __device__ __forceinline__ void group(const f32x4 (&v)[2][2], const pg8::Unit& u, int ai, int m, int wr, int wc, int fr, int fq) const {
        const int row = u.pm * 256 + wr * 64 + fr + ai * 128 + m * 16;
        emit(v, rstd[row], u, (size_t)row * ldc + u.pn * 256 + wc * 32 + 4 * fq);
    }
    __device__ __forceinline__ void operator()(const f32x4 (&acc)[2][2][4][2], const pg8::Unit& u, int wr, int wc, int fr, int fq) const {
        const int row0 = u.pm * 256 + wr * 64 + fr;
        float rr[2][4];
#pragma unroll
        for (int ai = 0; ai < 2; ++ai)
#pragma unroll
            for (int m = 0; m < 4; ++m) rr[ai][m] = rs[u.slot * 256 + wr * 64 + fr + ai * 128 + m * 16];
#pragma unroll
        for (int ai = 0; ai < 2; ++ai)
#pragma unroll
            for (int m = 0; m < 4; ++m) { const f32x4 v[2][2] = {{acc[ai][0][m][0], acc[ai][0][m][1]}, {acc[ai][1][m][0], acc[ai][1][m][1]}};
                emit(v, rr[ai][m], u, (size_t)(row0 + ai * 128 + m * 16) * ldc + u.pn * 256 + wc * 32 + 4 * fq); }
    }
};
struct EpiStoreF32 {
    static constexpr bool PERM = false, AFTER_DRAIN = false;
    float* C; int ldc;
    __device__ __forceinline__ void group(const f32x4 (&v)[2][2], const pg8::Unit& u, int ai, int m, int wr, int wc, int fr, int fq) const {
        float* rowp = C + (size_t)(u.pm * 256 + wr * 64 + fr + ai * 128 + m * 16) * ldc + u.pn * 256 + wc * 32 + 4 * fq;
#pragma unroll
        for (int bj = 0; bj < 2; ++bj)
#pragma unroll
            for (int n = 0; n < 2; ++n) *(f32x4*)(rowp + bj * 128 + n * 16) = v[bj][n];
    }
    __device__ __forceinline__ void operator()(const f32x4 (&acc)[2][2][4][2], const pg8::Unit& u, int wr, int wc, int fr, int fq) const {
#pragma unroll
        for (int ai = 0; ai < 2; ++ai)
#pragma unroll
            for (int m = 0; m < 4; ++m) { const f32x4 v[2][2] = {{acc[ai][0][m][0], acc[ai][0][m][1]}, {acc[ai][1][m][0], acc[ai][1][m][1]}}; group(v, u, ai, m, wr, wc, fr, fq); }
    }
};
struct EpiGLU {
    static constexpr bool PERM = false, AFTER_DRAIN = false;
    const bf16_t* Y; const float* bias; bf16_t* MIX;
    __device__ __forceinline__ void group(const f32x4 (&v)[2][2], const pg8::Unit& u, int ai, int m, int wr, int wc, int fr, int fq) const {
        const int row = u.pm * 256 + wr * 64 + fr + ai * 128 + m * 16, col0 = u.pn * 256 + wc * 32 + 4 * fq;
#pragma unroll
        for (int bj = 0; bj < 2; ++bj)
#pragma unroll
            for (int n = 0; n < 2; ++n) { const int col = col0 + bj * 128 + n * 16;
                const u32x2 yw = *(const u32x2*)(Y + (size_t)row * 512 + col); const f32x4 y = {__uint_as_float(yw.x << 16), __uint_as_float(yw.x & 0xffff0000u), __uint_as_float(yw.y << 16), __uint_as_float(yw.y & 0xffff0000u)}, b = *(const f32x4*)(bias + col), a = v[bj][n] + b;
                u32x2 w; w.x = cvt_pk_bf16(y[0] * sigmoid_f(a[0]), y[1] * sigmoid_f(a[1])); w.y = cvt_pk_bf16(y[2] * sigmoid_f(a[2]), y[3] * sigmoid_f(a[3]));
                *(u32x2*)(MIX + (size_t)row * D + col) = w; }
    }
    __device__ __forceinline__ void operator()(const f32x4 (&acc)[2][2][4][2], const pg8::Unit& u, int wr, int wc, int fr, int fq) const {
#pragma unroll
        for (int ai = 0; ai < 2; ++ai)
#pragma unroll
            for (int m = 0; m < 4; ++m) { const f32x4 v[2][2] = {{acc[ai][0][m][0], acc[ai][0][m][1]}, {acc[ai][1][m][0], acc[ai][1][m][1]}}; group(v, u, ai, m, wr, wc, fr, fq); }
    }
};

__device__ __forceinline__ int gu_rowmap(int h, int type) {
    const int pn = h >> 7, r = h & 127, wc = r >> 5, r2 = r & 31, fq = r2 >> 3, n = (r2 >> 2) & 1, i = r2 & 3;
    return 256 * pn + 128 * type + 32 * wc + 16 * n + 4 * fq + i;
}
struct ConvJob { const float* src; bf16_t* dst; const float* nw; int K, N, ldd, koff, mode; };
constexpr int CONV_NJ = 12;
constexpr int CONV_TILES_LAYER = 704 * 6 + 768 + 16 + 256 + 3 + 3 + 6;
__device__ __forceinline__ void conv_decode(const Args& a, int T, ConvJob& J, int& tk, int& tn) {
    const int l = T / CONV_TILES_LAYER; int r = T % CONV_TILES_LAYER;
    unsigned char* wl = a.ws + WS_W + (size_t)l * W_LAYER;
    const int cnt[CONV_NJ] = {704, 704, 704, 768, 16, 256, 704, 704, 704, 3, 3, 6};
    int j = 0;
#pragma unroll
    for (int q = 0; q < CONV_NJ - 1; ++q) { if (j == q && r >= cnt[q]) { r -= cnt[q]; j = q + 1; } }
    J.koff = 0; J.mode = 0; J.nw = nullptr;
    switch (j) {
        case 0:  J.src = inp(a, I_G1) + (size_t)l * D * DFF;  J.dst = (bf16_t*)(wl + W_GU1);  J.K = D;   J.N = DFF; J.ldd = D;   J.mode = 1; J.nw = inp(a, I_NORM1) + l * D; break;
        case 1:  J.src = inp(a, I_U1) + (size_t)l * D * DFF;  J.dst = (bf16_t*)(wl + W_GU1);  J.K = D;   J.N = DFF; J.ldd = D;   J.mode = 2; J.nw = inp(a, I_NORM1) + l * D; break;
        case 2:  J.src = inp(a, I_D1) + (size_t)l * D * DFF;  J.dst = (bf16_t*)(wl + W_DN1);  J.K = DFF; J.N = D;   J.ldd = DFF; break;
        case 3:  J.src = inp(a, I_WIN) + (size_t)l * D * NIN; J.dst = (bf16_t*)(wl + W_WIN);  J.K = D;   J.N = NIN; J.ldd = D;   J.nw = inp(a, I_NORMM) + l * D; break;
        case 4:  J.src = inp(a, I_WGLU) + (size_t)l * 512 * 512; J.dst = (bf16_t*)(wl + W_GLU); J.K = 512; J.N = 512; J.ldd = 512; break;
        case 5:  J.src = inp(a, I_WOUT) + (size_t)l * D * D;  J.dst = (bf16_t*)(wl + W_WOUT); J.K = D;   J.N = D;   J.ldd = D;   break;
        case 6:  J.src = inp(a, I_G2F) + (size_t)l * D * DFF; J.dst = (bf16_t*)(wl + W_GU2);  J.K = D;   J.N = DFF; J.ldd = D;   J.mode = 1; J.nw = inp(a, I_NORM2) + l * D; break;
        case 7:  J.src = inp(a, I_U2F) + (size_t)l * D * DFF; J.dst = (bf16_t*)(wl + W_GU2);  J.K = D;   J.N = DFF; J.ldd = D;   J.mode = 2; J.nw = inp(a, I_NORM2) + l * D; break;
        case 8:  J.src = inp(a, I_D2F) + (size_t)l * D * DFF; J.dst = (bf16_t*)(wl + W_DN2);  J.K = DFF; J.N = D;   J.ldd = DFF; break;
        case 9:  J.src = inp(a, I_W2) + (size_t)l * 64 * 768;  J.dst = (bf16_t*)(wl + W_LORA); J.K = 64;  J.N = 768; J.ldd = 256; J.koff = 0;   break;
        case 10: J.src = inp(a, I_A2) + (size_t)l * 64 * 768;  J.dst = (bf16_t*)(wl + W_LORA); J.K = 64;  J.N = 768; J.ldd = 256; J.koff = 64;  break;
        default: J.src = inp(a, I_G2) + (size_t)l * 128 * 768; J.dst = (bf16_t*)(wl + W_LORA); J.K = 128; J.N = 768; J.ldd = 256; J.koff = 128; break;
    }
    const int ntn = J.N / 256; tk = r / ntn; tn = r % ntn;
}
__device__ __forceinline__ void conv_load(const ConvJob& J, int tk, int tn, int tid, float4 (&v)[8], float (&sc)[8]) {
#pragma unroll
    for (int i = 0; i < 8; ++i) { const int e = tid + 512 * i, r = e >> 6, c4 = e & 63; sc[i] = J.nw ? J.nw[tk * 64 + r] : 1.0f; const f32x4 t = __builtin_nontemporal_load((const f32x4*)(J.src + (size_t)(tk * 64 + r) * J.N + tn * 256 + 4 * c4)); v[i].x = t[0]; v[i].y = t[1]; v[i].z = t[2]; v[i].w = t[3]; }
}
__device__ __forceinline__ void conv_tiles(const Args& a, int T0, int Tend, int step, MK_LDS float* tile  ) {
    const int tid = otid();
    int T = T0; if (T >= Tend) return;
    ConvJob J; int tk, tn; conv_decode(a, T, J, tk, tn);
    float4 v[8]; float sc[8]; conv_load(J, tk, tn, tid, v, sc);
    for (;;) {
        __syncthreads();
#pragma unroll
        for (int i = 0; i < 8; ++i) { const int e = tid + 512 * i, r = e >> 6, c4 = e & 63; MK_LDS float* t = tile + r * 289 + c4; t[0] = v[i].x * sc[i]; t[72] = v[i].y * sc[i]; t[144] = v[i].z * sc[i]; t[216] = v[i].w * sc[i]; }
        const ConvJob Jc = J; const int ctk = tk, ctn = tn;
        T += step; const bool more = T < Tend;
        if (more) { conv_decode(a, T, J, tk, tn); conv_load(J, tk, tn, tid, v, sc); }
        __syncthreads();
        { const int n = tid >> 1, kh = tid & 1, ng = ctn * 256 + n;
          const int drow = Jc.mode == 0 ? ng : gu_rowmap(ng, Jc.mode - 1);
          bf16_t* dp = Jc.dst + (size_t)drow * Jc.ldd + Jc.koff + ctk * 64 + 32 * kh;
#pragma unroll
          for (int m = 0; m < 4; ++m) { float f[8];
#pragma unroll
              for (int j = 0; j < 8; ++j) f[j] = tile[(32 * kh + 8 * m + j) * 289 + (n & 3) * 72 + (n >> 2)];
              u32x4 w; w.x = cvt_pk_bf16(f[0], f[1]); w.y = cvt_pk_bf16(f[2], f[3]); w.z = cvt_pk_bf16(f[4], f[5]); w.w = cvt_pk_bf16(f[6], f[7]);
              *(u32x4*)(dp + 8 * m) = w; } }
        if (!more) break;
    }
    __syncthreads();
}
constexpr int CONV_TICKETS = (CONV_TILES_LAYER + 3) / 4;
__device__ __forceinline__ void conv_work(const Args& a, int j, int max_tickets, MK_LDS unsigned char* lds) {
    if (j >= NL) return;
    const int tid = otid();
    unsigned* cnt = (unsigned*)(a.ws + WS_CTL) + CW_CONV + 64 * j;
    volatile MK_LDS unsigned* qw = (volatile MK_LDS unsigned*)(lds + MISC_OFF + 32);
    for (int it = 0; max_tickets < 0 || it < max_tickets; ++it) {
        __syncthreads();
        if (tid == 0) qw[0] = __hip_atomic_fetch_add(cnt, 1u, __ATOMIC_RELAXED, __HIP_MEMORY_SCOPE_AGENT);
        __syncthreads();
        const int t = (int)qw[0];
        if (t >= CONV_TICKETS) break;
        const int T0 = j * CONV_TILES_LAYER + 4 * t, Te = (j + 1) * CONV_TILES_LAYER;
        conv_tiles(a, T0, (T0 + 4 < Te ? T0 + 4 : Te), 1, (MK_LDS float*)lds);
    }
}
__device__ __forceinline__ void phase_prologue(const Args& a, MK_LDS float* tile  ) {
    const int tid = otid(), G = gridDim.x;
    { const int lane = tid & 63, wave = tid >> 6, stride = G * 8; float* rstd = (float*)(a.ws + WS_HB);
      for (int row = blockIdx.x * 8 + wave; row < NTOK; row += stride) {
          const float4* src = (const float4*)(row < NPR ? inp(a, I_XP) + (size_t)row * D : inp(a, I_XS) + (size_t)(row - NPR) * D);
          u32x2* dst = (u32x2*)((bf16_t*)(a.ws + WS_X) + (size_t)row * D);
          float4 v[8]; float s = 0.f;
#pragma unroll
          for (int j = 0; j < 8; ++j) v[j] = src[lane + 64 * j];
#pragma unroll
          for (int j = 0; j < 8; ++j) { u32x2 w; w.x = cvt_pk_bf16(v[j].x, v[j].y); w.y = cvt_pk_bf16(v[j].z, v[j].w); dst[lane + 64 * j] = w;
              const float a0 = __uint_as_float(w.x << 16), a1 = __uint_as_float(w.x & 0xffff0000u), a2 = __uint_as_float(w.y << 16), a3 = __uint_as_float(w.y & 0xffff0000u);
              s += (a0 * a0 + a1 * a1) + (a2 * a2 + a3 * a3); }
          s = wave_sum(s);
          if (lane == 0) rstd[row] = rsqrtf(s * (1.0f / D) + NORM_EPS); } }
    conv_tiles(a, blockIdx.x, CONV_TILES_LAYER, G, tile);
}
constexpr int RS_OFF = 131072;
__device__ __forceinline__ const MK_LDS float* stage_rstd(const MK_LDS int* tab, const float* rstd, MK_LDS unsigned char* lds) {
    MK_LDS float* rs = (MK_LDS float*)(lds + RS_OFF); const int tid = otid();
    __syncthreads();
#pragma unroll
    for (int i0 = 0; i0 < 8; i0 += 2) { const int i = i0 + (tid >> 8); if (tab[8 * i + 7] != 0 && tab[8 * i + 4] < 0) rs[i * 256 + (tid & 255)] = rstd[tab[8 * i] * 256 + (tid & 255)]; }
    __syncthreads();
    return rs;
}
__device__ __forceinline__ void phase_rstd(const bf16_t* X, float* rstd) {
    const int tid = otid(), lane = tid & 63, wave = tid >> 6;
    const int stride = gridDim.x * 8;
    for (int row0 = blockIdx.x * 8 + wave; row0 < NTOK; row0 += 2 * stride) {
        const int row1 = row0 + stride; const bool has1 = row1 < NTOK;
        const u32x4* xr0 = (const u32x4*)(X + (size_t)row0 * D); const u32x4* xr1 = (const u32x4*)(X + (size_t)(has1 ? row1 : row0) * D);
        u32x4 v0[4], v1[4]; float s0 = 0.f, s1 = 0.f;
#pragma unroll
        for (int j = 0; j < 4; ++j) { v0[j] = xr0[lane + 64 * j]; v1[j] = xr1[lane + 64 * j]; }
#pragma unroll
        for (int j = 0; j < 4; ++j)
#pragma unroll
            for (int e = 0; e < 4; ++e) { const float a0 = __uint_as_float(v0[j][e] << 16), a1 = __uint_as_float(v0[j][e] & 0xffff0000u), b0 = __uint_as_float(v1[j][e] << 16), b1 = __uint_as_float(v1[j][e] & 0xffff0000u);
                s0 += a0 * a0 + a1 * a1; s1 += b0 * b0 + b1 * b1; }
        s0 = wave_sum(s0); s1 = wave_sum(s1);
        if (lane == 0) { rstd[row0] = rsqrtf(s0 * (1.0f / D) + NORM_EPS); if (has1) rstd[row1] = rsqrtf(s1 * (1.0f / D) + NORM_EPS); }
    }
}
__device__ __forceinline__ void phase_rmsnorm(const bf16_t* X, const float* w, bf16_t* ob, float* of) {
    const int tid = otid(), lane = tid & 63, wave = tid >> 6;
    const int stride = gridDim.x * 8;
    for (int row0 = blockIdx.x * 8 + wave; row0 < NTOK; row0 += 2 * stride) {
        const int row1 = row0 + stride; const bool has1 = row1 < NTOK;
        const u32x4* xr0 = (const u32x4*)(X + (size_t)row0 * D); const u32x4* xr1 = (const u32x4*)(X + (size_t)(has1 ? row1 : row0) * D);
        u32x4 v0[4], v1[4]; float s0 = 0.f, s1 = 0.f;
#pragma unroll
        for (int j = 0; j < 4; ++j) { v0[j] = xr0[lane + 64 * j]; v1[j] = xr1[lane + 64 * j]; }
#pragma unroll
        for (int j = 0; j < 4; ++j)
#pragma unroll
            for (int e = 0; e < 4; ++e) { const float a0 = __uint_as_float(v0[j][e] << 16), a1 = __uint_as_float(v0[j][e] & 0xffff0000u), b0 = __uint_as_float(v1[j][e] << 16), b1 = __uint_as_float(v1[j][e] & 0xffff0000u);
                s0 += a0 * a0 + a1 * a1; s1 += b0 * b0 + b1 * b1; }
        s0 = wave_sum(s0); s1 = wave_sum(s1);
        const float r0 = rsqrtf(s0 * (1.0f / D) + NORM_EPS), r1 = rsqrtf(s1 * (1.0f / D) + NORM_EPS);
#pragma unroll
        for (int j = 0; j < 4; ++j) { const float4 g0 = ((const float4*)w)[2 * (lane + 64 * j)], g1 = ((const float4*)w)[2 * (lane + 64 * j) + 1];
            const float g[8] = {g0.x, g0.y, g0.z, g0.w, g1.x, g1.y, g1.z, g1.w};
#pragma unroll
            for (int rw = 0; rw < 2; ++rw) { if (rw == 1 && !has1) break;
                const u32x4 v = rw ? v1[j] : v0[j]; const float r = rw ? r1 : r0; const int row = rw ? row1 : row0;
                float y[8];
#pragma unroll
                for (int e = 0; e < 4; ++e) { y[2 * e] = __uint_as_float(v[e] << 16) * r * g[2 * e]; y[2 * e + 1] = __uint_as_float(v[e] & 0xffff0000u) * r * g[2 * e + 1]; }
                if (ob) { u32x4 p; p.x = cvt_pk_bf16(y[0], y[1]); p.y = cvt_pk_bf16(y[2], y[3]); p.z = cvt_pk_bf16(y[4], y[5]); p.w = cvt_pk_bf16(y[6], y[7]); *(u32x4*)(ob + (size_t)row * D + 8 * (lane + 64 * j)) = p; }
                else { float4 o0, o1; o0.x = y[0]; o0.y = y[1]; o0.z = y[2]; o0.w = y[3]; o1.x = y[4]; o1.y = y[5]; o1.z = y[6]; o1.w = y[7];
                       ((float4*)(of + (size_t)row * D))[2 * (lane + 64 * j)] = o0; ((float4*)(of + (size_t)row * D))[2 * (lane + 64 * j) + 1] = o1; } } }
    }
}

__device__ __forceinline__ const float* rwkv_prev(const float* P, const float* shift0, int row) {
    if (row < NPR) return (row & (TP - 1)) ? P + (size_t)(row - 1) * NIN + O_RW : nullptr;
    const int rs = row - NPR;
    return (rs & 7) ? P + (size_t)(row - 1) * NIN + O_RW : shift0 + (size_t)(rs >> 3) * RSW;
}
__device__ __forceinline__ void rwkv_prep(const Args& a, int l, MK_LDS unsigned char* lds, int t0, int t1) {
    const int tid = otid(), lane = tid & 63, wave = tid >> 6, ln = lane & 15, q = lane >> 4, G = gridDim.x;
    const float* P = (const float*)(a.ws + WS_P); float* RWB = (float*)(a.ws + WS_RW); float* BON = (float*)(a.ws + WS_BONUS);
    const float* mu = inp(a, I_MU) + l * RSW; const float* w0 = inp(a, I_W0) + l * 768; const float* a0 = inp(a, I_A0) + l * 768;
    const float* kkp = inp(a, I_KK) + l * 768; const float* kap = inp(a, I_KA) + l * 768; const float* rkp = inp(a, I_RK) + l * 768;
    const float* shift0 = inp(a, I_SHIFT) + (size_t)l * BS * RSW;
    const bf16_t* lora = (const bf16_t*)(a.ws + WS_W + (size_t)l * W_LAYER + W_LORA);
    int cur_tb = -1;
    for (int task = t0; task < t1; ++task) {
        const int tb = task / 12, head = task % 12;
        if (tb != cur_tb) {
            __syncthreads();
            const int r = tid >> 2, cg = tid & 3, row = tb * 128 + r;
            const float* zp = P + (size_t)row * NIN + O_RW + 2304 + cg * 64;
            const float* pv = rwkv_prev(P, shift0, row); const float* pvp = pv ? pv + 2304 + cg * 64 : nullptr;
            const float* mup = mu + 2304 + cg * 64;
#pragma unroll 4
            for (int j = 0; j < 16; ++j) {
                const float4 z = *(const float4*)(zp + 4 * j), m = *(const float4*)(mup + 4 * j);
                float4 p = {0.f, 0.f, 0.f, 0.f}; if (pvp) p = *(const float4*)(pvp + 4 * j);
                float v0 = z.x + (p.x - z.x) * m.x, v1 = z.y + (p.y - z.y) * m.y, v2 = z.z + (p.z - z.z) * m.z, v3 = z.w + (p.w - z.w) * m.w;
                if (cg == 0) { v0 = tanh_f(v0); v1 = tanh_f(v1); v2 = tanh_f(v2); v3 = tanh_f(v3); }
                else if (cg >= 2) { v0 = sigmoid_f(v0); v1 = sigmoid_f(v1); v2 = sigmoid_f(v2); v3 = sigmoid_f(v3); }
                u32x2 w; w.x = cvt_pk_bf16(v0, v1); w.y = cvt_pk_bf16(v2, v3);
                *(MK_LDS u32x2*)(lds + r * 528 + (cg * 64 + 4 * j) * 2) = w;
            }
            __syncthreads(); cur_tb = tb;
        }
        bf16x8 af[8];
#pragma unroll
        for (int s = 0; s < 8; ++s) af[s] = *(const MK_LDS bf16x8*)(lds + (16 * wave + ln) * 528 + (32 * s + 8 * q) * 2);
        f32x4 aw[4], aa[4], ag[4];
#pragma unroll
        for (int nt = 0; nt < 4; ++nt) {
            aw[nt] = (f32x4){0.f, 0.f, 0.f, 0.f}; aa[nt] = aw[nt]; ag[nt] = aw[nt];
            const bf16_t* bp = lora + (size_t)(head * 64 + nt * 16 + ln) * 256 + 8 * q;
#pragma unroll
            for (int s = 0; s < 8; ++s) { const bf16x8 b = *(const bf16x8*)(bp + 32 * s);
                if (s < 2) aw[nt] = __builtin_amdgcn_mfma_f32_16x16x32_bf16(af[s], b, aw[nt], 0, 0, 0);
                else if (s < 4) aa[nt] = __builtin_amdgcn_mfma_f32_16x16x32_bf16(af[s], b, aa[nt], 0, 0, 0);
                else ag[nt] = __builtin_amdgcn_mfma_f32_16x16x32_bf16(af[s], b, ag[nt], 0, 0, 0); }
        }
        const int rbase = tb * 128 + 16 * wave + 4 * q;
        float ss[4] = {0.f, 0.f, 0.f, 0.f}, bn[4] = {0.f, 0.f, 0.f, 0.f}, kkraw[4][4], av[4][4];
#pragma unroll
        for (int nt = 0; nt < 4; ++nt) {
            const int c = 16 * nt + ln, C = head * 64 + c;
            const float mr = mu[C], mk_ = mu[768 + C], mv = mu[1536 + C], w0c = w0[C], a0c = a0[C], kkc = kkp[C], kac = kap[C], rkc = rkp[C];
#pragma unroll
            for (int i = 0; i < 4; ++i) {
                const int row = rbase + i;
                const float* zp = P + (size_t)row * NIN + O_RW + C; const float* pv = rwkv_prev(P, shift0, row);
                const float zr = zp[0], zk = zp[768], zv = zp[1536];
                float pr = 0.f, pk = 0.f, pvv = 0.f; if (pv) { pr = pv[C]; pk = pv[768 + C]; pvv = pv[1536 + C]; }
                const float rr = zr + (pr - zr) * mr, kz = zk + (pk - zk) * mk_, vz = zv + (pvv - zv) * mv;
                const float x = -(w0c + aw[nt][i]);
                const float sp = fmaxf(x, 0.f) + __logf(1.0f + __expf(-fabsf(x)));
                const float wl = -sp - 0.5f, dec = __expf(-__expf(wl));
                const float aval = sigmoid_f(a0c + aa[nt][i]);
                const float kr = kz * kkc, kmod = kz * (1.0f + (aval - 1.0f) * kac);
                kkraw[nt][i] = kr; av[nt][i] = aval; ss[i] += kr * kr; bn[i] += rr * kmod * rkc;
                float* o = RWB + ((size_t)row * 12 + head) * 448 + c;
                o[0] = rr; o[64] = kmod; o[128] = vz; o[192] = dec; o[384] = ag[nt][i];
            }
        }
#pragma unroll
        for (int i = 0; i < 4; ++i) { ss[i] = row16_sum(ss[i]); bn[i] = row16_sum(bn[i]); }
#pragma unroll
        for (int nt = 0; nt < 4; ++nt)
#pragma unroll
            for (int i = 0; i < 4; ++i) { const float kn = kkraw[nt][i] * rsqrtf(fmaxf(ss[i], 1e-24f));
                float* o = RWB + ((size_t)(rbase + i) * 12 + head) * 448 + 16 * nt + ln; o[256] = kn; o[320] = kn * av[nt][i]; }
        if (ln == 0) {
#pragma unroll
            for (int i = 0; i < 4; ++i) BON[(size_t)(rbase + i) * 12 + head] = bn[i]; }
    }
}
__device__ __forceinline__ void hgrn_prep(const Args& a, int l) {
    float* P = (float*)(a.ws + WS_P); const float* lbr = inp(a, I_LBRAW);
    const size_t n4 = (size_t)1024 * 384;
    const int tid = otid();
    for (size_t e = (size_t)blockIdx.x * 512 + tid; e < n4; e += (size_t)gridDim.x * 512) {
        const int row = NPR + (int)(e / 384), c4 = (int)(e % 384);
        float4* p = (float4*)(P + (size_t)row * NIN + O_HG) + c4; float4 v = *p;
        if (c4 < 192) { v.x = silu_f(v.x); v.y = silu_f(v.y); v.z = silu_f(v.z); v.w = silu_f(v.w); }
        else {
            const int c = 4 * (c4 - 192); float lb[4];
#pragma unroll
            for (int k = 0; k < 4; ++k) { const float r0 = lbr[c + k], r1 = lbr[768 + c + k], r2 = lbr[1536 + c + k], r3 = lbr[2304 + c + k];
                const float mx = fmaxf(fmaxf(r0, r1), fmaxf(r2, r3)), e0 = expf(r0 - mx), e1 = expf(r1 - mx), e2 = expf(r2 - mx), e3 = expf(r3 - mx), inv = 1.0f / (e0 + e1 + e2 + e3);
                lb[k] = (l == 0 ? 0.f : l == 1 ? e1 : l == 2 ? e1 + e2 : e1 + e2 + e3) * inv; }
            v.x = lb[0] + (1.0f - lb[0]) * sigmoid_f(v.x); v.y = lb[1] + (1.0f - lb[1]) * sigmoid_f(v.y); v.z = lb[2] + (1.0f - lb[2]) * sigmoid_f(v.z); v.w = lb[3] + (1.0f - lb[3]) * sigmoid_f(v.w);
        }
        *p = v;
    }
}

typedef short bf16x4 __attribute__((ext_vector_type(4)));
struct S5Par { float abr, abi; bf16x4 bre[4], bim[4]; };
constexpr int S5_UT = 0, S5_XT = 4096, S5_BU = 4096 + 4352, S5_WAVE_LDS = 4096 + 4352 + 9216;
__device__ __forceinline__ void s5_setup(const Args& a, int l, int g, int lane, S5Par& S, MK_LDS unsigned char* wl) {
    const int p = lane, ln = lane & 15, q = lane >> 4, gp = (l * 32 + g) * 64 + p;
    const float ar = inp(a, I_AARE)[gp], ai = inp(a, I_AAIM)[gp], dt = expf(inp(a, I_LOGDT)[l * 32 + g]);
    const float em = expm1f(ar * dt), ang = ai * dt, cs = cosf(ang), sn = sinf(ang), sh = sinf(0.5f * ang), mag = em + 1.0f;
    S.abr = mag * cs; S.abi = mag * sn;
    const float m1r = em * cs - 2.0f * sh * sh, m1i = mag * sn, den = 1.0f / (ar * ar + ai * ai);
    const float cr = (m1r * ar + m1i * ai) * den, ci = (m1i * ar - m1r * ai) * den;
    const float4* br = (const float4*)(inp(a, I_BRE) + (size_t)gp * 16); const float4* bi = (const float4*)(inp(a, I_BIM) + (size_t)gp * 16);
    MK_LDS unsigned char* img = wl + S5_BU + p * 64;
#pragma unroll
    for (int j = 0; j < 4; ++j) { const float4 r = br[j], i = bi[j];
        *(MK_LDS u32x2*)(img + 8 * j) = (u32x2){cvt_pk_bf16(cr * r.x - ci * i.x, cr * r.y - ci * i.y), cvt_pk_bf16(cr * r.z - ci * i.z, cr * r.w - ci * i.w)};
        *(MK_LDS u32x2*)(img + 32 + 8 * j) = (u32x2){cvt_pk_bf16(cr * i.x + ci * r.x, cr * i.y + ci * r.y), cvt_pk_bf16(cr * i.z + ci * r.z, cr * i.w + ci * r.w)}; }
    __builtin_amdgcn_wave_barrier(); asm volatile("s_waitcnt lgkmcnt(0)" ::: "memory");
#pragma unroll
    for (int pt = 0; pt < 4; ++pt) { const MK_LDS unsigned char* rowp = wl + S5_BU + (16 * pt + ln) * 64;
        S.bre[pt] = __builtin_bit_cast(bf16x4, *(const MK_LDS u32x2*)(rowp + 8 * q)); S.bim[pt] = __builtin_bit_cast(bf16x4, *(const MK_LDS u32x2*)(rowp + 32 + 8 * q)); }
    __builtin_amdgcn_wave_barrier(); asm volatile("s_waitcnt lgkmcnt(0)" ::: "memory");
}
__device__ __forceinline__ void s5_load_u(const float* P, int row0, int nrows, int g, int lane, MK_LDS float* ut) {
    const f32x4 z = {0.f, 0.f, 0.f, 0.f};
    const int row = row0 + (lane < nrows ? lane : 0);
    if (row0 < NPR) { const bf16_t* src = (const bf16_t*)P + (size_t)row * NIN + g * 16;
#pragma unroll
        for (int j = 0; j < 4; ++j) *(MK_LDS f32x4*)(ut + lane * 16 + 4 * j) = lane < nrows ? pbf4(src + 4 * j) : z; }
    else { const f32x4* src = (const f32x4*)(P + (size_t)row * NIN + g * 16);
#pragma unroll
        for (int j = 0; j < 4; ++j) *(MK_LDS f32x4*)(ut + lane * 16 + 4 * j) = lane < nrows ? src[j] : z; }
    __builtin_amdgcn_wave_barrier(); asm volatile("s_waitcnt lgkmcnt(0)" ::: "memory");
}
template <bool XOUT> __device__ __forceinline__ void s5_block(const S5Par& S, MK_LDS unsigned char* wl, int sb, int ns, int lane, float& xr, float& xi) {
    const int ln = lane & 15, q = lane >> 4;
    const MK_LDS float* ut = (const MK_LDS float*)(wl + S5_UT);
    bf16x4 af; { const f32x4 u0 = *(const MK_LDS f32x4*)(ut + (16 * sb + ln) * 16 + 4 * q); u32x2 w; w.x = cvt_pk_bf16(u0[0], u0[1]); w.y = cvt_pk_bf16(u0[2], u0[3]); af = __builtin_bit_cast(bf16x4, w); }
#pragma unroll
    for (int pt = 0; pt < 4; ++pt) { const f32x4 z = {0.f, 0.f, 0.f, 0.f};
        f32x4 br = __builtin_amdgcn_mfma_f32_16x16x16bf16_1k(af, S.bre[pt], z, 0, 0, 0), bi = __builtin_amdgcn_mfma_f32_16x16x16bf16_1k(af, S.bim[pt], z, 0, 0, 0);
        *(MK_LDS f32x4*)(wl + S5_BU + (16 * pt + ln) * 144 + 16 * q) = br; *(MK_LDS f32x4*)(wl + S5_BU + (16 * pt + ln) * 144 + 64 + 16 * q) = bi; }
    __builtin_amdgcn_wave_barrier(); asm volatile("s_waitcnt lgkmcnt(0)" ::: "memory");
    f32x4 rr[4], ii[4];
#pragma unroll
    for (int j = 0; j < 4; ++j) { rr[j] = *(const MK_LDS f32x4*)(wl + S5_BU + lane * 144 + 16 * j); ii[j] = *(const MK_LDS f32x4*)(wl + S5_BU + lane * 144 + 64 + 16 * j); }
#pragma unroll
    for (int t = 0; t < 16; ++t) { if (t < ns) { const float nxr = S.abr * xr - S.abi * xi + rr[t >> 2][t & 3], nxi = S.abr * xi + S.abi * xr + ii[t >> 2][t & 3]; xr = nxr; xi = nxi; }
        if (XOUT) { *(MK_LDS unsigned short*)(wl + S5_XT + t * 272 + lane * 2) = bf16_1(xr); *(MK_LDS unsigned short*)(wl + S5_XT + t * 272 + 128 + lane * 2) = bf16_1(xi); } }
    __builtin_amdgcn_wave_barrier(); asm volatile("s_waitcnt lgkmcnt(0)" ::: "memory");
}
__device__ __forceinline__ void s5a_wave(const Args& a, int l, int wt, MK_LDS unsigned char* wl) {
    const int lane = otid() & 63, n = wt >> 10, g = (wt >> 5) & 31, c = wt & 31;
    const float* P = (const float*)(a.ws + WS_P); float* E = (float*)(a.ws + WS_S5E);
    S5Par S; s5_setup(a, l, g, lane, S, wl);
    s5_load_u(P, n * TP + c * 64, 64, g, lane, (MK_LDS float*)(wl + S5_UT));
    float xr = 0.f, xi = 0.f;
#pragma unroll 1
    for (int sb = 0; sb < 4; ++sb) s5_block<false>(S, wl, sb, 16, lane, xr, xi);
    float* e = E + (size_t)((n * 32 + g) * 32 + c) * 128; e[lane] = xr; e[64 + lane] = xi;
    __builtin_amdgcn_wave_barrier();
}
__device__ __forceinline__ void s5c_wave(const Args& a, int l, int wt, MK_LDS unsigned char* wl) {
    const int lane = otid() & 63, ln = lane & 15, q = lane >> 4;
    const float* P = (const float*)(a.ws + WS_P); const float* E = (const float*)(a.ws + WS_S5E);
    bf16_t* YB = (bf16_t*)(a.ws + WS_YS5B);
    const MK_LDS float* ut = (const MK_LDS float*)(wl + S5_UT); const MK_LDS unsigned char* xt = wl + S5_XT;
    int n, g, c, T, row0; bool last; float xr, xi; float* ore; float* oim;
    const bool prompt = wt < 4096;
    if (prompt) { n = wt >> 10; g = (wt >> 5) & 31; c = wt & 31; T = 64; row0 = n * TP + c * 64; last = (c == 31);
        ore = a.out + O_S5RE_P + (size_t)((l * 4 + n) * 32 + g) * 64; oim = a.out + O_S5IM_P + (size_t)((l * 4 + n) * 32 + g) * 64; }
    else { const int i = wt - 4096; n = i >> 5; g = i & 31; c = 0; T = 8; row0 = NPR + n * 8; last = true;
        ore = a.out + O_S5RE_S + (size_t)((l * 128 + n) * 32 + g) * 64; oim = a.out + O_S5IM_S + (size_t)((l * 128 + n) * 32 + g) * 64; }
    S5Par S; s5_setup(a, l, g, lane, S, wl);
    if (prompt) {
        float pr = S.abr, pi = S.abi;
#pragma unroll
        for (int k = 0; k < 6; ++k) { const float t = pr * pr - pi * pi; pi = 2.0f * pr * pi; pr = t; }
        xr = 0.f; xi = 0.f;
        const float* e = E + (size_t)((n * 32 + g) * 32) * 128;
        for (int j0 = 0; j0 < c; j0 += 8) {
            float er[8], ei[8];
#pragma unroll
            for (int j = 0; j < 8; ++j) { const bool ok = j0 + j < c; er[j] = ok ? e[(j0 + j) * 128 + lane] : 0.f; ei[j] = ok ? e[(j0 + j) * 128 + 64 + lane] : 0.f; }
#pragma unroll
            for (int j = 0; j < 8; ++j) if (j0 + j < c) { const float t = xr * pr - xi * pi + er[j]; xi = xr * pi + xi * pr + ei[j]; xr = t; } }
    } else { const size_t so = (size_t)((l * 128 + n) * 32 + g) * 64 + lane; xr = inp(a, I_S5RE)[so]; xi = inp(a, I_S5IM)[so]; }
    s5_load_u(P, row0, T, g, lane, (MK_LDS float*)(wl + S5_UT));
    bf16x8 cb[4];
#pragma unroll
    for (int s = 0; s < 4; ++s) { const float* cp = (s < 2 ? inp(a, I_CRE) : inp(a, I_CIM)) + (size_t)((l * 32 + g) * 16 + ln) * 64 + 32 * (s & 1) + 8 * q;
        const float4 c0 = *(const float4*)cp, c1 = *(const float4*)(cp + 4); const float sg = s < 2 ? 1.0f : -1.0f;
        u32x4 w; w.x = cvt_pk_bf16(sg * c0.x, sg * c0.y); w.y = cvt_pk_bf16(sg * c0.z, sg * c0.w); w.z = cvt_pk_bf16(sg * c1.x, sg * c1.y); w.w = cvt_pk_bf16(sg * c1.z, sg * c1.w);
        cb[s] = __builtin_bit_cast(bf16x8, w); }
    const float dpar = inp(a, I_S5D)[l * 512 + g * 16 + ln];
#pragma unroll 1
    for (int sb = 0; sb * 16 < T; ++sb) {
        const int ns = (T - sb * 16) < 16 ? (T - sb * 16) : 16;
        s5_block<true>(S, wl, sb, ns, lane, xr, xi);
        f32x4 acc = {0.f, 0.f, 0.f, 0.f};
#pragma unroll
        for (int s = 0; s < 4; ++s) { const bf16x8 af = *(const MK_LDS bf16x8*)(xt + ln * 272 + (32 * s + 8 * q) * 2); acc = __builtin_amdgcn_mfma_f32_16x16x32_bf16(af, cb[s], acc, 0, 0, 0); }
#pragma unroll
        for (int i = 0; i < 4; ++i) { const int tl = 4 * q + i;
            if (tl < ns) { const int tt = sb * 16 + tl; const float yv = gelu_tanh_f(acc[i] + dpar * ut[tt * 16 + ln]);
                const size_t o = (size_t)(row0 + tt) * 512 + g * 16 + ln; YB[o] = bf16_1(yv); } }
        __builtin_amdgcn_wave_barrier(); asm volatile("s_waitcnt lgkmcnt(0)" ::: "memory");
    }
    if (last) { ore[lane] = xr; oim[lane] = xi; }
}

constexpr int SC_CH = 32;
__device__ __forceinline__ void rwkv_scan_task(const float* RWB, float* YRW, int row0, int T, int head, int half, const float* s0, float* sout, MK_LDS float* buf) {
    const int tid = otid(), lane = tid & 63, wave = tid >> 6, kq = lane & 15, rq = lane >> 4, vrow = half * 32 + wave * 4 + rq;
    float S0 = 0.f, S1 = 0.f, S2 = 0.f, S3 = 0.f;
    if (s0) { const float4 t = *(const float4*)(s0 + vrow * 64 + 4 * kq); S0 = t.x; S1 = t.y; S2 = t.z; S3 = t.w; }
    const int nch = (T + SC_CH - 1) / SC_CH;
    f32x4 st[6];
    { const int ns = T < SC_CH ? T : SC_CH;
#pragma unroll
      for (int i = 0; i < 6; ++i) { const int e = tid + 512 * i, step = e / 96, o4 = e - step * 96;
          if (step < ns) ((MK_LDS f32x4*)buf)[e] = *(const f32x4*)(RWB + ((size_t)(row0 + step) * 12 + head) * 448 + 4 * o4); } }
    __syncthreads();
    for (int c = 0; c < nch; ++c) {
        const int t0 = c * SC_CH, ns = (T - t0) < SC_CH ? (T - t0) : SC_CH;
        const bool more = c + 1 < nch; const int ns2 = more ? ((T - t0 - SC_CH) < SC_CH ? (T - t0 - SC_CH) : SC_CH) : 0;
        if (more) {
#pragma unroll
            for (int i = 0; i < 6; ++i) { const int e = tid + 512 * i, step = e / 96, o4 = e - step * 96;
                if (step < ns2) st[i] = *(const f32x4*)(RWB + ((size_t)(row0 + t0 + SC_CH + step) * 12 + head) * 448 + 4 * o4); } }
        const MK_LDS float* B = buf + (c & 1) * (SC_CH * 384);
        f32x4 r4 = *(const MK_LDS f32x4*)(B + 4 * kq), k4 = *(const MK_LDS f32x4*)(B + 64 + 4 * kq), d4 = *(const MK_LDS f32x4*)(B + 192 + 4 * kq),
               kk4 = *(const MK_LDS f32x4*)(B + 256 + 4 * kq), b4 = *(const MK_LDS f32x4*)(B + 320 + 4 * kq); float vv = B[128 + vrow];
        for (int t = 0; t < ns; ++t) {
            const int tn = (t + 1 < ns) ? t + 1 : t; const MK_LDS float* Bn = B + tn * 384;
            const f32x4 nr4 = *(const MK_LDS f32x4*)(Bn + 4 * kq), nk4 = *(const MK_LDS f32x4*)(Bn + 64 + 4 * kq), nd4 = *(const MK_LDS f32x4*)(Bn + 192 + 4 * kq),
                         nkk4 = *(const MK_LDS f32x4*)(Bn + 256 + 4 * kq), nb4 = *(const MK_LDS f32x4*)(Bn + 320 + 4 * kq); const float nvv = Bn[128 + vrow];
            float dot = (S0 * kk4.x + S1 * kk4.y) + (S2 * kk4.z + S3 * kk4.w); dot = row16_sum(dot);
            const float sa = -dot;
            S0 = S0 * d4.x + (sa * b4.x + vv * k4.x); S1 = S1 * d4.y + (sa * b4.y + vv * k4.y); S2 = S2 * d4.z + (sa * b4.z + vv * k4.z); S3 = S3 * d4.w + (sa * b4.w + vv * k4.w);
            float y = (S0 * r4.x + S1 * r4.y) + (S2 * r4.z + S3 * r4.w); y = row16_sum(y);
            if (kq == 0) YRW[(size_t)(row0 + t0 + t) * 768 + head * 64 + vrow] = y;
            r4 = nr4; k4 = nk4; d4 = nd4; kk4 = nkk4; b4 = nb4; vv = nvv;
        }
        if (more) {
            MK_LDS f32x4* Bw = (MK_LDS f32x4*)(buf + ((c + 1) & 1) * (SC_CH * 384));
#pragma unroll
            for (int i = 0; i < 6; ++i) { const int e = tid + 512 * i, step = e / 96; if (step < ns2) Bw[e] = st[i]; } }
        __syncthreads();
    }
    float4 o; o.x = S0; o.y = S1; o.z = S2; o.w = S3; *(float4*)(sout + vrow * 64 + 4 * kq) = o;
}
constexpr int HG_STEP = 288;
__device__ __forceinline__ void hgrn_stage_load(const float* P, int row_first, int nsteps, int head, int cb, int tid, f32x4 (&st)[5]) {
#pragma unroll
    for (int i = 0; i < 5; ++i) { const int e = tid + 512 * i, step = e / 72, o4 = e - step * 72;
        if (step < nsteps) { const float* rp = P + (size_t)(row_first + step) * NIN + O_HG + head * 128;
            const float* src = o4 < 32 ? rp + 4 * o4 : (o4 < 64 ? rp + 768 + 4 * (o4 - 32) : rp + 1536 + cb * 32 + 4 * (o4 - 64));
            st[i] = *(const f32x4*)src; } }
}
__device__ __forceinline__ void hgrn_scan_task(const float* P, float* OHG, int row0, int T, int head, int cb, const float* s0, float* sout, MK_LDS float* buf) {
    const int tid = otid(), lane = tid & 63, wave = tid >> 6, kq = lane & 15, rq = lane >> 4, cl = wave * 4 + rq, col = cb * 32 + cl;
    float S[8];
#pragma unroll
    for (int j = 0; j < 8; ++j) S[j] = s0 ? s0[(size_t)(8 * kq + j) * 128 + col] : 0.f;
    const int nch = (T + SC_CH - 1) / SC_CH;
    f32x4 st[5];
    { const int ns = T < SC_CH ? T : SC_CH; hgrn_stage_load(P, row0, ns, head, cb, tid, st);
#pragma unroll
      for (int i = 0; i < 5; ++i) { const int e = tid + 512 * i, step = e / 72; if (step < ns) ((MK_LDS f32x4*)buf)[e] = st[i]; } }
    __syncthreads();
    for (int c = 0; c < nch; ++c) {
        const int t0 = c * SC_CH, ns = (T - t0) < SC_CH ? (T - t0) : SC_CH;
        const bool more = c + 1 < nch; const int ns2 = more ? ((T - t0 - SC_CH) < SC_CH ? (T - t0 - SC_CH) : SC_CH) : 0;
        if (more) hgrn_stage_load(P, row0 + t0 + SC_CH, ns2, head, cb, tid, st);
        const MK_LDS float* B = buf + (c & 1) * (SC_CH * HG_STEP);
        f32x4 qa = *(const MK_LDS f32x4*)(B + 8 * kq), qb = *(const MK_LDS f32x4*)(B + 8 * kq + 4), fa = *(const MK_LDS f32x4*)(B + 128 + 8 * kq), fb = *(const MK_LDS f32x4*)(B + 128 + 8 * kq + 4);
        float vv = B[256 + cl];
        for (int t = 0; t < ns; ++t) {
            const int tn = (t + 1 < ns) ? t + 1 : t; const MK_LDS float* Bn = B + tn * HG_STEP;
            const f32x4 nqa = *(const MK_LDS f32x4*)(Bn + 8 * kq), nqb = *(const MK_LDS f32x4*)(Bn + 8 * kq + 4), nfa = *(const MK_LDS f32x4*)(Bn + 128 + 8 * kq), nfb = *(const MK_LDS f32x4*)(Bn + 128 + 8 * kq + 4);
            const float nvv = Bn[256 + cl];
            S[0] = fa.x * (S[0] - vv) + vv; S[1] = fa.y * (S[1] - vv) + vv; S[2] = fa.z * (S[2] - vv) + vv; S[3] = fa.w * (S[3] - vv) + vv;
            S[4] = fb.x * (S[4] - vv) + vv; S[5] = fb.y * (S[5] - vv) + vv; S[6] = fb.z * (S[6] - vv) + vv; S[7] = fb.w * (S[7] - vv) + vv;
            float o = ((qa.x * S[0] + qa.y * S[1]) + (qa.z * S[2] + qa.w * S[3])) + ((qb.x * S[4] + qb.y * S[5]) + (qb.z * S[6] + qb.w * S[7]));
            o = row16_sum(o);
            if (kq == 0) OHG[(size_t)(row0 + t0 + t) * 768 + head * 128 + col] = o;
            qa = nqa; qb = nqb; fa = nfa; fb = nfb; vv = nvv;
        }
        if (more) {
            MK_LDS f32x4* Bw = (MK_LDS f32x4*)(buf + ((c + 1) & 1) * (SC_CH * HG_STEP));
#pragma unroll
            for (int i = 0; i < 5; ++i) { const int e = tid + 512 * i, step = e / 72; if (step < ns2) Bw[e] = st[i]; } }
        __syncthreads();
    }
#pragma unroll
    for (int j = 0; j < 8; ++j) sout[(size_t)(8 * kq + j) * 128 + col] = S[j];
}

}

namespace mk {
constexpr int RC_KT = 0, RC_ZT = 8192, RC_RH = 16384, RC_N = 24576, RC_Y0 = 40960, RC_VV = 57344, RC_GG = 73728, RC_PC = 90112, RC_BO = 90368, RC_ST = 90624, RC_BYTES = 98816;
constexpr int SL = 9216;
constexpr int S_KT = 0, S_RT = 1, S_BT = 2, S_KQ = 3, S_KTT = 4, S_VT = 5, S_KBT = 6, S_BBT = 7, S_AKKT = 8, S_ARK = 9, S_ARB = 10, S_TM = 11, S_TT = 12, S_U0T = 13;
constexpr int S_W = S_BT, S_G = S_KQ;
constexpr int LA_OFF = 14 * SL;
constexpr int XC_OFF = LA_OFF + 64 * 65 * 4;
constexpr int RA_LDS_END = XC_OFF + (4 + 8) * 64 * 4;
constexpr int IN_OFF = 8 * SL;

__device__ __forceinline__ bf16x8 ldfrag(const MK_LDS unsigned char* slot, int tile, int ks, int ln, int q) { return *(const MK_LDS bf16x8*)(slot + (16 * tile + ln) * 144 + (32 * ks + 8 * q) * 2); }
__device__ __forceinline__ f32x4 mfma16(bf16x8 a, bf16x8 b, f32x4 c) { return __builtin_amdgcn_mfma_f32_16x16x32_bf16(a, b, c, 0, 0, 0); }
__device__ __forceinline__ u32x2 pack4(float a, float b, float c, float d) { u32x2 w; w.x = cvt_pk_bf16(a, b); w.y = cvt_pk_bf16(c, d); return w; }
__device__ __forceinline__ float bf2f(unsigned short h) { return __uint_as_float(((unsigned)h) << 16); }
#define WG_SYNC() do { asm volatile("s_waitcnt lgkmcnt(0)" ::: "memory"); __builtin_amdgcn_s_barrier(); asm volatile("" ::: "memory"); } while (0)

__device__ __forceinline__ void rwkv_chunk_a(const Args& a, int l, int n, int head, int c, MK_LDS unsigned char* lds) {
    const int tid = otid(), lane = tid & 63, wave = tid >> 6, ln = lane & 15, q = lane >> 4;
    const bf16_t* P = (const bf16_t*)(a.ws + WS_P);
    const float* mu = inp(a, I_MU) + l * RSW; const float* w0 = inp(a, I_W0) + l * 768; const float* a0 = inp(a, I_A0) + l * 768;
    const float* kkp = inp(a, I_KK) + l * 768; const float* kap = inp(a, I_KA) + l * 768; const float* rkp = inp(a, I_RK) + l * 768;
    const bf16_t* lora = (const bf16_t*)(a.ws + WS_W + (size_t)l * W_LAYER + W_LORA);
    unsigned char* rec = a.ws + WS_RWC + (size_t)((n * 12 + head) * 32 + c) * RC_BYTES;
    const int R0 = n * TP + c * 64;
    MK_LDS float* LA = (MK_LDS float*)(lds + LA_OFF); MK_LDS float* XC = (MK_LDS float*)(lds + XC_OFF);
    { const int r = tid >> 3, sub = tid & 7, row = R0 + r;
      const bf16_t* zp = P + (size_t)row * NIN + O_RW + 2304 + sub * 32; const float* mup = mu + 2304 + sub * 32;
      const bool hasp = (row & (TP - 1)) != 0; const bf16_t* pp = zp - NIN;
      u32x4 zw[4], pw[4];
#pragma unroll
      for (int j = 0; j < 4; ++j) { zw[j] = *(const u32x4*)(zp + 8 * j); pw[j] = (u32x4){0u, 0u, 0u, 0u}; if (hasp) pw[j] = *(const u32x4*)(pp + 8 * j); }
#pragma unroll
      for (int j = 0; j < 8; ++j) { const float4 m = *(const float4*)(mup + 4 * j);
          const unsigned za = zw[j >> 1][2 * (j & 1)], zb = zw[j >> 1][2 * (j & 1) + 1], pa = pw[j >> 1][2 * (j & 1)], pb = pw[j >> 1][2 * (j & 1) + 1];
          const float4 z = {__uint_as_float(za << 16), __uint_as_float(za & 0xffff0000u), __uint_as_float(zb << 16), __uint_as_float(zb & 0xffff0000u)};
          const float4 p = {__uint_as_float(pa << 16), __uint_as_float(pa & 0xffff0000u), __uint_as_float(pb << 16), __uint_as_float(pb & 0xffff0000u)};
          float v0 = z.x + (p.x - z.x) * m.x, v1 = z.y + (p.y - z.y) * m.y, v2 = z.z + (p.z - z.z) * m.z, v3 = z.w + (p.w - z.w) * m.w;
          if (sub < 2) { v0 = tanh_f(v0); v1 = tanh_f(v1); v2 = tanh_f(v2); v3 = tanh_f(v3); } else if (sub >= 4) { v0 = sigmoid_f(v0); v1 = sigmoid_f(v1); v2 = sigmoid_f(v2); v3 = sigmoid_f(v3); }
          *(MK_LDS u32x2*)(lds + IN_OFF + r * 528 + (sub * 32 + 4 * j) * 2) = pack4(v0, v1, v2, v3); } }
    WG_SYNC();
    const int mt = wave & 3, nh = wave >> 2;
    f32x4 aw[2], aa[2], ag[2];
    { bf16x8 af[8];
#pragma unroll
      for (int s = 0; s < 8; ++s) af[s] = *(const MK_LDS bf16x8*)(lds + IN_OFF + (16 * mt + ln) * 528 + (32 * s + 8 * q) * 2);
#pragma unroll
      for (int nl = 0; nl < 2; ++nl) { aw[nl] = (f32x4){0.f, 0.f, 0.f, 0.f}; aa[nl] = aw[nl]; ag[nl] = aw[nl];
          const bf16_t* bp = lora + (size_t)(head * 64 + (2 * nh + nl) * 16 + ln) * 256 + 8 * q;
#pragma unroll
          for (int s = 0; s < 8; ++s) { const bf16x8 b = *(const bf16x8*)(bp + 32 * s);
              if (s < 2) aw[nl] = mfma16(af[s], b, aw[nl]); else if (s < 4) aa[nl] = mfma16(af[s], b, aa[nl]); else ag[nl] = mfma16(af[s], b, ag[nl]); } } }
    float rr[2][4], km[2][4], vz[2][4], kn[2][4], bb[2][4], ss[4] = {0.f, 0.f, 0.f, 0.f}, bn[4] = {0.f, 0.f, 0.f, 0.f};
    const int tb = 16 * mt + 4 * q;
    {
      float zr[2][4], zk[2][4], zv[2][4], pr[2][4], pk[2][4], pv[2][4], par[2][8];
#pragma unroll
      for (int nl = 0; nl < 2; ++nl) { const int C = head * 64 + 16 * (2 * nh + nl) + ln;
          par[nl][0] = mu[C]; par[nl][1] = mu[768 + C]; par[nl][2] = mu[1536 + C]; par[nl][3] = w0[C]; par[nl][4] = a0[C]; par[nl][5] = kkp[C]; par[nl][6] = kap[C]; par[nl][7] = rkp[C];
#pragma unroll
          for (int i = 0; i < 4; ++i) { const int row = R0 + tb + i; const bf16_t* zp = P + (size_t)row * NIN + O_RW + C; const bool hp = (row & (TP - 1)) != 0;
              zr[nl][i] = pbf(zp); zk[nl][i] = pbf(zp + 768); zv[nl][i] = pbf(zp + 1536);
              pr[nl][i] = hp ? pbf(zp - NIN) : 0.f; pk[nl][i] = hp ? pbf(zp + 768 - NIN) : 0.f; pv[nl][i] = hp ? pbf(zp + 1536 - NIN) : 0.f; } }
#pragma unroll
      for (int nl = 0; nl < 2; ++nl) { const int cc = 16 * (2 * nh + nl) + ln;
#pragma unroll
          for (int i = 0; i < 4; ++i) {
              const float r_ = zr[nl][i] + (pr[nl][i] - zr[nl][i]) * par[nl][0], kz = zk[nl][i] + (pk[nl][i] - zk[nl][i]) * par[nl][1], v_ = zv[nl][i] + (pv[nl][i] - zv[nl][i]) * par[nl][2];
              const float x = -(par[nl][3] + aw[nl][i]); const float sp = fmaxf(x, 0.f) + __logf(1.0f + __expf(-fabsf(x)));
              const float ldec = -__expf(-sp - 0.5f);
              const float aval = sigmoid_f(par[nl][4] + aa[nl][i]); const float kr = kz * par[nl][5], kmod = kz * (1.0f + (aval - 1.0f) * par[nl][6]);
              rr[nl][i] = r_; km[nl][i] = kmod; vz[nl][i] = v_; kn[nl][i] = kr; bb[nl][i] = aval; ss[i] += kr * kr; bn[i] += r_ * kmod * par[nl][7];
              LA[(tb + i) * 65 + cc] = ldec; } }
#pragma unroll
      for (int nl = 0; nl < 2; ++nl) { const int cc = 16 * (2 * nh + nl) + ln;
          *(MK_LDS u32x2*)(lds + S_TT * SL + cc * 144 + tb * 2) = pack4(ag[nl][0], ag[nl][1], ag[nl][2], ag[nl][3]); } }
#pragma unroll
    for (int i = 0; i < 4; ++i) { ss[i] = row16_sum(ss[i]); bn[i] = row16_sum(bn[i]); if (ln == 0) { XC[nh * 64 + tb + i] = ss[i]; XC[128 + nh * 64 + tb + i] = bn[i]; } }
    WG_SYNC();
    { const int cs = tid & 63, sg = tid >> 6; float pfx[8], run = 0.f;
#pragma unroll
      for (int j = 0; j < 8; ++j) { run += LA[(8 * sg + j) * 65 + cs]; pfx[j] = run; }
      XC[256 + sg * 64 + cs] = run;
      WG_SYNC();
      float off = 0.f;
#pragma unroll
      for (int s2 = 0; s2 < 7; ++s2) off += (s2 < sg) ? XC[256 + s2 * 64 + cs] : 0.f;
#pragma unroll
      for (int j = 0; j < 8; ++j) LA[(8 * sg + j) * 65 + cs] = off + pfx[j]; }
    WG_SYNC();
#pragma unroll
    for (int nl = 0; nl < 2; ++nl) {
        const int cc = 16 * (2 * nh + nl) + ln; const float lpC = LA[63 * 65 + cc];
        float o_kt[4], o_rt[4], o_bt[4], o_kq[4], o_kb[4], o_bb[4];
#pragma unroll
        for (int i = 0; i < 4; ++i) { const int t = tb + i; const float lp = LA[t * 65 + cc], lpm = t ? LA[(t - 1) * 65 + cc] : 0.f;
            const float tot = XC[t] + XC[64 + t]; const float kkn = kn[nl][i] * rsqrtf(fmaxf(tot, 1e-24f)), bv = kkn * bb[nl][i];
            const float e_m = __expf(lpm), e_p = __expf(lp), e_n = __expf(-lp), e_c = __expf(lpC - lp);
            o_kt[i] = kkn * e_m; o_rt[i] = rr[nl][i] * e_p; o_bt[i] = bv * e_n; o_kq[i] = km[nl][i] * e_n; o_kb[i] = km[nl][i] * e_c; o_bb[i] = bv * e_c;
            *(MK_LDS unsigned short*)(lds + S_KT * SL + t * 144 + cc * 2) = bf16_1(o_kt[i]); *(MK_LDS unsigned short*)(lds + S_RT * SL + t * 144 + cc * 2) = bf16_1(o_rt[i]);
            *(MK_LDS unsigned short*)(lds + S_BT * SL + t * 144 + cc * 2) = bf16_1(o_bt[i]); *(MK_LDS unsigned short*)(lds + S_KQ * SL + t * 144 + cc * 2) = bf16_1(o_kq[i]);
            if (t == 63) *(float*)(rec + RC_PC + cc * 4) = e_p; }
        *(MK_LDS u32x2*)(lds + S_KTT * SL + cc * 144 + tb * 2) = pack4(o_kt[0], o_kt[1], o_kt[2], o_kt[3]);
        *(MK_LDS u32x2*)(lds + S_VT * SL + cc * 144 + tb * 2) = pack4(vz[nl][0], vz[nl][1], vz[nl][2], vz[nl][3]);
        *(MK_LDS u32x2*)(lds + S_KBT * SL + cc * 144 + tb * 2) = pack4(o_kb[0], o_kb[1], o_kb[2], o_kb[3]);
        *(MK_LDS u32x2*)(lds + S_BBT * SL + cc * 144 + tb * 2) = pack4(o_bb[0], o_bb[1], o_bb[2], o_bb[3]);
    }
    if (nh == 0 && ln == 0) {
#pragma unroll
        for (int i = 0; i < 4; ++i) *(float*)(rec + RC_BO + (tb + i) * 4) = XC[128 + tb + i] + XC[192 + tb + i]; }
    WG_SYNC();
    { const int rr_ = tid >> 3, pc_ = (tid & 7) * 16;
      *(u32x4*)(rec + RC_KT + rr_ * 128 + pc_) = *(const MK_LDS u32x4*)(lds + S_KT * SL + rr_ * 144 + pc_);
      *(u32x4*)(rec + RC_VV + rr_ * 128 + pc_) = *(const MK_LDS u32x4*)(lds + S_VT * SL + rr_ * 144 + pc_);
      *(u32x4*)(rec + RC_GG + rr_ * 128 + pc_) = *(const MK_LDS u32x4*)(lds + S_TT * SL + rr_ * 144 + pc_); }
    { const int mi = mt;
      const bf16x8 fk0 = ldfrag(lds + S_KT * SL, mi, 0, ln, q), fk1 = ldfrag(lds + S_KT * SL, mi, 1, ln, q), fr0 = ldfrag(lds + S_RT * SL, mi, 0, ln, q), fr1 = ldfrag(lds + S_RT * SL, mi, 1, ln, q);
      bf16x8 fb[2][2], fq[2][2];
#pragma unroll
      for (int nl = 0; nl < 2; ++nl)
#pragma unroll
          for (int ks = 0; ks < 2; ++ks) { fb[nl][ks] = ldfrag(lds + S_BT * SL, 2 * nh + nl, ks, ln, q); fq[nl][ks] = ldfrag(lds + S_KQ * SL, 2 * nh + nl, ks, ln, q); }
      asm volatile("s_waitcnt lgkmcnt(0)" ::: "memory");
#pragma unroll
      for (int nl = 0; nl < 2; ++nl) { const int ni = 2 * nh + nl;
          f32x4 akb = {0.f, 0.f, 0.f, 0.f}, akk = akb, ark = akb, arb = akb;
          if (ni <= mi) {
              akb = mfma16(fk0, fb[nl][0], akb); akk = mfma16(fk0, fq[nl][0], akk); ark = mfma16(fq[nl][0], fr0, ark); arb = mfma16(fb[nl][0], fr0, arb);
              akb = mfma16(fk1, fb[nl][1], akb); akk = mfma16(fk1, fq[nl][1], akk); ark = mfma16(fq[nl][1], fr1, ark); arb = mfma16(fb[nl][1], fr1, arb); }
          { const int s = 16 * ni + ln;
            float kkv[4];
#pragma unroll
            for (int i = 0; i < 4; ++i) { const int t = 16 * mi + 4 * q + i; LA[t * 65 + s] = (s < t) ? akb[i] : 0.f; kkv[i] = (s < t) ? akk[i] : 0.f; }
            *(MK_LDS u32x2*)(lds + S_AKKT * SL + s * 144 + (16 * mi + 4 * q) * 2) = pack4(kkv[0], kkv[1], kkv[2], kkv[3]); }
          { const int t = 16 * mi + ln, s0 = 16 * ni + 4 * q;
            *(MK_LDS u32x2*)(lds + S_ARK * SL + t * 144 + s0 * 2) = pack4(s0 <= t ? ark[0] : 0.f, s0 + 1 <= t ? ark[1] : 0.f, s0 + 2 <= t ? ark[2] : 0.f, s0 + 3 <= t ? ark[3] : 0.f);
            *(MK_LDS u32x2*)(lds + S_ARB * SL + t * 144 + s0 * 2) = pack4(s0 <= t ? arb[0] : 0.f, s0 + 1 <= t ? arb[1] : 0.f, s0 + 2 <= t ? arb[2] : 0.f, s0 + 3 <= t ? arb[3] : 0.f); } } }
    WG_SYNC();
    if (wave == 0) { const int o = 16 * q, j = ln; float Tc[16];
#pragma unroll
        for (int p4 = 0; p4 < 4; ++p4) { float Lr[4][16];
#pragma unroll
            for (int rr = 0; rr < 4; ++rr)
#pragma unroll
                for (int e = 0; e < 16; ++e) Lr[rr][e] = (e < 4 * p4 + rr) ? LA[(o + 4 * p4 + rr) * 65 + o + e] : 0.f;
#pragma unroll
            for (int rr = 0; rr < 4; ++rr) { const int r = 4 * p4 + rr; float acc = (r == j) ? 1.0f : 0.f;
#pragma unroll
                for (int e = 0; e < 16; ++e) if (e < r) acc -= (e >= j) ? Lr[rr][e] * Tc[e] : 0.f;
                Tc[r] = (r >= j) ? acc : 0.f; } }
        __builtin_amdgcn_wave_barrier();
#pragma unroll
        for (int r = 0; r < 16; ++r) LA[(o + r) * 65 + o + j] = Tc[r]; }
    WG_SYNC();
#pragma unroll
    for (int bi = 1; bi < 4; ++bi) {
        const int col = lane, r0 = 2 * wave; float x0 = 0.f, x1 = 0.f; const bool act = col < 16 * bi;
        if (act) {
#pragma unroll
            for (int sb = 0; sb < bi; ++sb) { float tv[16], l0[16], l1[16];
#pragma unroll
                for (int e = 0; e < 16; ++e) { const int s = 16 * sb + e; tv[e] = LA[s * 65 + col]; l0[e] = LA[(16 * bi + r0) * 65 + s]; l1[e] = LA[(16 * bi + r0 + 1) * 65 + s]; }
#pragma unroll
                for (int e = 0; e < 16; ++e) { x0 += l0[e] * tv[e]; x1 += l1[e] * tv[e]; } } }
        WG_SYNC();
        if (act) { LA[(16 * bi + r0) * 65 + col] = x0; LA[(16 * bi + r0 + 1) * 65 + col] = x1; }
        WG_SYNC();
        float t0 = 0.f, t1 = 0.f;
        if (act) { float xv[16], d0[16], d1[16];
#pragma unroll
            for (int e = 0; e < 16; ++e) { xv[e] = LA[(16 * bi + e) * 65 + col]; d0[e] = LA[(16 * bi + r0) * 65 + 16 * bi + e]; d1[e] = LA[(16 * bi + r0 + 1) * 65 + 16 * bi + e]; }
#pragma unroll
            for (int e = 0; e < 16; ++e) { t0 -= d0[e] * xv[e]; t1 -= d1[e] * xv[e]; } }
        WG_SYNC();
        if (act) { LA[(16 * bi + r0) * 65 + col] = t0; LA[(16 * bi + r0 + 1) * 65 + col] = t1; }
        WG_SYNC();
    }
    { const int t = tid >> 3, s0 = (tid & 7) * 8; float tv[8];
#pragma unroll
      for (int j = 0; j < 8; ++j) { const int s = s0 + j; tv[j] = (s <= t) ? LA[t * 65 + s] : 0.f; *(MK_LDS unsigned short*)(lds + S_TT * SL + s * 144 + t * 2) = bf16_1(tv[j]); }
      *(MK_LDS u32x2*)(lds + S_TM * SL + t * 144 + s0 * 2) = pack4(tv[0], tv[1], tv[2], tv[3]); *(MK_LDS u32x2*)(lds + S_TM * SL + t * 144 + (s0 + 4) * 2) = pack4(tv[4], tv[5], tv[6], tv[7]); }
    WG_SYNC();
    { const int mi = mt;
      bf16x8 ftm[2], farb[2], fttm[2], fakk[2][2], fttn[2][2], fbb[2][2];
#pragma unroll
      for (int ks = 0; ks < 2; ++ks) { ftm[ks] = ldfrag(lds + S_TM * SL, mi, ks, ln, q); farb[ks] = ldfrag(lds + S_ARB * SL, mi, ks, ln, q); fttm[ks] = ldfrag(lds + S_TT * SL, mi, ks, ln, q);
#pragma unroll
          for (int nl = 0; nl < 2; ++nl) { fakk[nl][ks] = ldfrag(lds + S_AKKT * SL, 2 * nh + nl, ks, ln, q); fttn[nl][ks] = ldfrag(lds + S_TT * SL, 2 * nh + nl, ks, ln, q); fbb[nl][ks] = ldfrag(lds + S_BBT * SL, 2 * nh + nl, ks, ln, q); } }
      asm volatile("s_waitcnt lgkmcnt(0)" ::: "memory");
      WG_SYNC();
#pragma unroll
      for (int nl = 0; nl < 2; ++nl) { const int ni = 2 * nh + nl;
          f32x4 w = {0.f, 0.f, 0.f, 0.f}, g = w, z = w;
#pragma unroll
          for (int ks = 0; ks < 2; ++ks) {
              w = mfma16(fakk[nl][ks], ftm[ks], w);
              g = mfma16(fttn[nl][ks], farb[ks], g);
              z = mfma16(fttm[ks], fbb[nl][ks], z); }
          *(u32x2*)(rec + RC_ZT + ((16 * ni + ln) * 64 + 16 * mi + 4 * q) * 2) = pack4(z[0], z[1], z[2], z[3]);
          *(MK_LDS u32x2*)(lds + S_W * SL + (16 * mi + ln) * 144 + (16 * ni + 4 * q) * 2) = pack4(w[0], w[1], w[2], w[3]);
          *(MK_LDS u32x2*)(lds + S_G * SL + (16 * mi + ln) * 144 + (16 * ni + 4 * q) * 2) = pack4(g[0], g[1], g[2], g[3]); } }
    WG_SYNC();
    { const int mi = mt;
      bf16x8 fw[2], fg[2], fvt[2][2], fktt[2][2]; u32x2 rtv[2];
#pragma unroll
      for (int ks = 0; ks < 2; ++ks) { fw[ks] = ldfrag(lds + S_W * SL, mi, ks, ln, q); fg[ks] = ldfrag(lds + S_G * SL, mi, ks, ln, q);
#pragma unroll
          for (int nl = 0; nl < 2; ++nl) { fvt[nl][ks] = ldfrag(lds + S_VT * SL, 2 * nh + nl, ks, ln, q); fktt[nl][ks] = ldfrag(lds + S_KTT * SL, 2 * nh + nl, ks, ln, q); } }
#pragma unroll
      for (int nl = 0; nl < 2; ++nl) rtv[nl] = *(const MK_LDS u32x2*)(lds + S_RT * SL + (16 * mi + ln) * 144 + (16 * (2 * nh + nl) + 4 * q) * 2);
      asm volatile("s_waitcnt lgkmcnt(0)" ::: "memory");
#pragma unroll
      for (int nl = 0; nl < 2; ++nl) { const int ni = 2 * nh + nl;
          f32x4 u = {0.f, 0.f, 0.f, 0.f}, gk = u;
#pragma unroll
          for (int ks = 0; ks < 2; ++ks) {
              u = mfma16(fw[ks], fvt[nl][ks], u);
              gk = mfma16(fktt[nl][ks], fg[ks], gk); }
          *(MK_LDS u32x2*)(lds + S_U0T * SL + (16 * ni + ln) * 144 + (16 * mi + 4 * q) * 2) = pack4(u[0], u[1], u[2], u[3]);
          const int t = 16 * mi + ln, k0 = 16 * ni + 4 * q;
          const float r0 = __uint_as_float(rtv[nl].x << 16), r1 = __uint_as_float(rtv[nl].x & 0xffff0000u), r2 = __uint_as_float(rtv[nl].y << 16), r3 = __uint_as_float(rtv[nl].y & 0xffff0000u);
          *(u32x2*)(rec + RC_RH + (t * 64 + k0) * 2) = pack4(r0 - gk[0], r1 - gk[1], r2 - gk[2], r3 - gk[3]); } }
    WG_SYNC();
    { const int mi = mt;
      bf16x8 fark[2], farb[2], fvm[2], fum[2], fvn[2][2], fun[2][2], fkb[2][2], fbb[2][2];
#pragma unroll
      for (int ks = 0; ks < 2; ++ks) { fark[ks] = ldfrag(lds + S_ARK * SL, mi, ks, ln, q); farb[ks] = ldfrag(lds + S_ARB * SL, mi, ks, ln, q); fvm[ks] = ldfrag(lds + S_VT * SL, mi, ks, ln, q); fum[ks] = ldfrag(lds + S_U0T * SL, mi, ks, ln, q);
#pragma unroll
          for (int nl = 0; nl < 2; ++nl) { const int ni = 2 * nh + nl; fvn[nl][ks] = ldfrag(lds + S_VT * SL, ni, ks, ln, q); fun[nl][ks] = ldfrag(lds + S_U0T * SL, ni, ks, ln, q); fkb[nl][ks] = ldfrag(lds + S_KBT * SL, ni, ks, ln, q); fbb[nl][ks] = ldfrag(lds + S_BBT * SL, ni, ks, ln, q); } }
      asm volatile("s_waitcnt lgkmcnt(0)" ::: "memory");
#pragma unroll
      for (int nl = 0; nl < 2; ++nl) { const int ni = 2 * nh + nl;
          f32x4 y1 = {0.f, 0.f, 0.f, 0.f}, y2 = y1, n1 = y1, n2 = y1;
#pragma unroll
          for (int ks = 0; ks < 2; ++ks) {
              y1 = mfma16(fark[ks], fvn[nl][ks], y1);
              y2 = mfma16(farb[ks], fun[nl][ks], y2);
              n1 = mfma16(fkb[nl][ks], fvm[ks], n1);
              n2 = mfma16(fbb[nl][ks], fum[ks], n2); }
          { const f32x4 yy = y1 - y2; *(u32x2*)(rec + RC_Y0 + ((mi * 4 + ni) * 64 + lane) * 8) = pack4(yy[0], yy[1], yy[2], yy[3]); }
          { const f32x4 nd = n1 - n2; *(u32x2*)(rec + RC_N + ((mi * 4 + ni) * 64 + lane) * 8) = pack4(nd[0], nd[1], nd[2], nd[3]); } } }
    WG_SYNC();
}

constexpr int SB_S = 0, SB_W1 = SL;
__device__ __forceinline__ void rwkv_chunk_b(const Args& a, int l, int n, int head, MK_LDS unsigned char* lds) {
    const int tid = otid(), lane = tid & 63, wave = tid >> 6, ln = lane & 15, q = lane >> 4;
    const int vi = wave & 3, kh = wave >> 2;
    f32x4 S[2]; S[0] = (f32x4){0.f, 0.f, 0.f, 0.f}; S[1] = S[0];
    unsigned char* rec0 = a.ws + WS_RWC + (size_t)((n * 12 + head) * 32) * RC_BYTES;
    bf16x8 fkA[2][2], fzA[2][2], fkB[2][2], fzB[2][2]; u32x2 nnA[2], nnB[2]; f32x4 pcA[2], pcB[2];
#define RB_LOAD_K(fk, rec) do { _Pragma("unroll") for (int kl = 0; kl < 2; ++kl) { const int tk = 2 * kh + kl; _Pragma("unroll") for (int ks = 0; ks < 2; ++ks) \
        fk[kl][ks] = *(const bf16x8*)((rec) + RC_KT + ((16 * tk + ln) * 64 + 32 * ks + 8 * q) * 2); } } while (0)
#define RB_LOAD_Z(fz, nn, pc, rec) do { _Pragma("unroll") for (int kl = 0; kl < 2; ++kl) { const int tk = 2 * kh + kl; _Pragma("unroll") for (int ks = 0; ks < 2; ++ks) \
        fz[kl][ks] = *(const bf16x8*)((rec) + RC_ZT + ((16 * tk + ln) * 64 + 32 * ks + 8 * q) * 2); \
        nn[kl] = *(const u32x2*)((rec) + RC_N + ((vi * 4 + tk) * 64 + lane) * 8); pc[kl] = *(const f32x4*)((rec) + RC_PC + (16 * tk + 4 * q) * 4); } } while (0)
#define RB_STEP(fk, fz, nn, pc, c) do { unsigned char* rec = rec0 + (size_t)(c) * RC_BYTES; \
          \
        _Pragma("unroll") for (int kl = 0; kl < 2; ++kl) { const u32x2 pk = pack4(S[kl][0], S[kl][1], S[kl][2], S[kl][3]); \
            *(MK_LDS u32x2*)(lds + SB_S + (16 * vi + ln) * 144 + (16 * (2 * kh + kl) + 4 * q) * 2) = pk; \
            *(u32x2*)(rec + RC_ST + ((16 * vi + ln) * 64 + 16 * (2 * kh + kl) + 4 * q) * 2) = pk; } \
        WG_SYNC(); \
          \
        _Pragma("unroll") for (int kl = 0; kl < 2; ++kl) { const int ti = 2 * kh + kl; f32x4 w = {0.f, 0.f, 0.f, 0.f}; \
            _Pragma("unroll") for (int ks = 0; ks < 2; ++ks) w = mfma16(fk[kl][ks], ldfrag(lds + SB_S, vi, ks, ln, q), w); \
            *(MK_LDS u32x2*)(lds + SB_W1 + (16 * vi + ln) * 144 + (16 * ti + 4 * q) * 2) = pack4(w[0], w[1], w[2], w[3]); } \
        if ((c) + 2 < 32) RB_LOAD_K(fk, rec + 2 * RC_BYTES); \
        WG_SYNC(); \
          \
        _Pragma("unroll") for (int kl = 0; kl < 2; ++kl) { f32x4 wz = {0.f, 0.f, 0.f, 0.f}; \
            _Pragma("unroll") for (int ks = 0; ks < 2; ++ks) wz = mfma16(fz[kl][ks], ldfrag(lds + SB_W1, vi, ks, ln, q), wz); \
            S[kl] = S[kl] * pc[kl] - wz + (f32x4){__uint_as_float(nn[kl].x << 16), __uint_as_float(nn[kl].x & 0xffff0000u), __uint_as_float(nn[kl].y << 16), __uint_as_float(nn[kl].y & 0xffff0000u)}; } \
        if ((c) + 2 < 32) RB_LOAD_Z(fz, nn, pc, rec + 2 * RC_BYTES); } while (0)
    RB_LOAD_K(fkA, rec0); RB_LOAD_Z(fzA, nnA, pcA, rec0); RB_LOAD_K(fkB, rec0 + RC_BYTES); RB_LOAD_Z(fzB, nnB, pcB, rec0 + RC_BYTES);
#pragma unroll
    for (int c = 0; c < 32; c += 2) { RB_STEP(fkA, fzA, nnA, pcA, c); RB_STEP(fkB, fzB, nnB, pcB, c + 1); }
#undef RB_STEP
#undef RB_LOAD_K
#undef RB_LOAD_Z
    float* so = a.out + O_WKV_P + (size_t)((l * 4 + n) * 12 + head) * 4096;
#pragma unroll
    for (int kl = 0; kl < 2; ++kl) *(f32x4*)(so + (16 * vi + ln) * 64 + 16 * (2 * kh + kl) + 4 * q) = S[kl];
    WG_SYNC();
}
__device__ __forceinline__ void rwkv_chunk_c_wave(const Args& a, int l, int wt) {
    const int lane = otid() & 63, ln = lane & 15, q = lane >> 4;
    const int ti = wt & 3, ch = wt >> 2, c = ch & 31, nh = ch >> 5, head = nh % 12, n = nh / 12;
    const unsigned char* rec = a.ws + WS_RWC + (size_t)ch * RC_BYTES;
    const float* lnw = inp(a, I_LNW) + l * 768 + head * 64; const float* lnb = inp(a, I_LNB) + l * 768 + head * 64;
    bf16_t* MIX = (bf16_t*)(a.ws + WS_MIX);
    const bf16x8 fr0 = *(const bf16x8*)(rec + RC_RH + ((16 * ti + ln) * 64 + 8 * q) * 2), fr1 = *(const bf16x8*)(rec + RC_RH + ((16 * ti + ln) * 64 + 32 + 8 * q) * 2);
    f32x4 y[4]; float bo[4], vv[4][4], gg[4][4];
#pragma unroll
    for (int vt = 0; vt < 4; ++vt) { { const u32x2 yw = *(const u32x2*)(rec + RC_Y0 + ((ti * 4 + vt) * 64 + lane) * 8); y[vt] = (f32x4){__uint_as_float(yw.x << 16), __uint_as_float(yw.x & 0xffff0000u), __uint_as_float(yw.y << 16), __uint_as_float(yw.y & 0xffff0000u)}; }
        const bf16x8 s0 = *(const bf16x8*)(rec + RC_ST + ((16 * vt + ln) * 64 + 8 * q) * 2), s1 = *(const bf16x8*)(rec + RC_ST + ((16 * vt + ln) * 64 + 32 + 8 * q) * 2);
        y[vt] = mfma16(fr0, s0, y[vt]); y[vt] = mfma16(fr1, s1, y[vt]);
        { const int cc = 16 * vt + ln; const u32x2 pv = *(const u32x2*)(rec + RC_VV + (cc * 64 + 16 * ti + 4 * q) * 2), pg = *(const u32x2*)(rec + RC_GG + (cc * 64 + 16 * ti + 4 * q) * 2);
          vv[vt][0] = __uint_as_float(pv.x << 16); vv[vt][1] = __uint_as_float(pv.x & 0xffff0000u); vv[vt][2] = __uint_as_float(pv.y << 16); vv[vt][3] = __uint_as_float(pv.y & 0xffff0000u);
          gg[vt][0] = __uint_as_float(pg.x << 16); gg[vt][1] = __uint_as_float(pg.x & 0xffff0000u); gg[vt][2] = __uint_as_float(pg.y << 16); gg[vt][3] = __uint_as_float(pg.y & 0xffff0000u); } }
#pragma unroll
    for (int i = 0; i < 4; ++i) bo[i] = *(const float*)(rec + RC_BO + (16 * ti + 4 * q + i) * 4);
#pragma unroll
    for (int i = 0; i < 4; ++i) { const int t = 16 * ti + 4 * q + i;
        float sm = (y[0][i] + y[1][i]) + (y[2][i] + y[3][i]); sm = row16_sum(sm); const float mean = sm * (1.0f / 64.0f);
        const float d0 = y[0][i] - mean, d1 = y[1][i] - mean, d2 = y[2][i] - mean, d3 = y[3][i] - mean; float vs = (d0 * d0 + d1 * d1) + (d2 * d2 + d3 * d3); vs = row16_sum(vs);
        const float rs = rsqrtf(vs * (1.0f / 64.0f) + 64e-5f); const float dd[4] = {d0, d1, d2, d3};
#pragma unroll
        for (int vt = 0; vt < 4; ++vt) { const int cc = 16 * vt + ln;
            MIX[(size_t)(n * TP + c * 64 + t) * D + 512 + head * 64 + cc] = bf16_1((dd[vt] * rs * lnw[cc] + lnb[cc] + bo[i] * vv[vt][i]) * gg[vt][i]); } }
}
}

namespace mk {
constexpr int HC_QP = 0, HC_OI = 16384, HC_UT = 49152, HC_EC = 114688, HC_ST = 115200, HC_BYTES = 147968;
constexpr int HL_QT = 0, HL_KT = 17408, HL_KBT = 34816, HL_VT = 53248, HL_ATT = 71680, HL_XS = 80896;
__device__ __forceinline__ bf16x8 ldfrag272(const MK_LDS unsigned char* base, int tile, int ks, int ln, int q) { return *(const MK_LDS bf16x8*)(base + (16 * tile + ln) * 272 + (32 * ks + 8 * q) * 2); }

__device__ __forceinline__ void hgrn_chunk_a(const Args& a, int l, int n, int head, int c, MK_LDS unsigned char* lds) {
    const int tid = otid(), lane = tid & 63, wave = tid >> 6, ln = lane & 15, q = lane >> 4;
    const bf16_t* P = (const bf16_t*)(a.ws + WS_P);
    unsigned char* rec = a.ws + WS_HGC + (size_t)((n * 6 + head) * 32 + c) * HC_BYTES;
    const int R0 = n * TP + c * 64;
    MK_LDS float* XS = (MK_LDS float*)(lds + HL_XS);
    {
      const int kc = tid & 127, sg = tid >> 7, C = head * 128 + kc;
      float lbv; { const float* lbr = inp(a, I_LBRAW); const float r0 = lbr[C], r1 = lbr[768 + C], r2 = lbr[1536 + C], r3 = lbr[2304 + C];
          const float mx = fmaxf(fmaxf(r0, r1), fmaxf(r2, r3)), e0 = expf(r0 - mx), e1 = expf(r1 - mx), e2 = expf(r2 - mx), e3 = expf(r3 - mx), inv = 1.0f / (e0 + e1 + e2 + e3);
          lbv = (l == 0 ? 0.f : l == 1 ? e1 : l == 2 ? e1 + e2 : e1 + e2 + e3) * inv; }
      float qv[16], kv[16], bv[16], vv[16], run = 0.f;
#pragma unroll
      for (int j = 0; j < 16; ++j) { const bf16_t* rp = P + (size_t)(R0 + 16 * sg + j) * NIN + O_HG + C;
          const float qq = pbf(rp), ff = pbf(rp + 768); vv[j] = pbf(rp + 1536);
          const float fg = lbv + (1.0f - lbv) * sigmoid_f(ff); qv[j] = silu_f(qq); kv[j] = 1.0f - fg; run += __logf(fg); bv[j] = run; }
      XS[sg * 128 + kc] = run;
      WG_SYNC();
      const float s0 = XS[kc], s1 = XS[128 + kc], s2 = XS[256 + kc], s3 = XS[384 + kc];
      const float off = sg == 0 ? 0.f : sg == 1 ? s0 : sg == 2 ? s0 + s1 : s0 + s1 + s2, bref = s0 + s1, bC = (s0 + s1) + (s2 + s3);
      float kb[16];
#pragma unroll
      for (int j = 0; j < 16; ++j) { const int t = 16 * sg + j; const float b = off + bv[j];
          *(unsigned short*)(rec + HC_QP + (t * 128 + kc) * 2) = bf16_1(qv[j] * __expf(b));
          *(MK_LDS unsigned short*)(lds + HL_QT + t * 272 + kc * 2) = bf16_1(qv[j] * __expf(b - bref));
          *(MK_LDS unsigned short*)(lds + HL_KT + t * 272 + kc * 2) = bf16_1(kv[j] * __expf(bref - b));
          kb[j] = kv[j] * __expf(bC - b); }
      *(MK_LDS u32x4*)(lds + HL_KBT + kc * 144 + (16 * sg) * 2) = (u32x4){cvt_pk_bf16(kb[0], kb[1]), cvt_pk_bf16(kb[2], kb[3]), cvt_pk_bf16(kb[4], kb[5]), cvt_pk_bf16(kb[6], kb[7])};
      *(MK_LDS u32x4*)(lds + HL_KBT + kc * 144 + (16 * sg + 8) * 2) = (u32x4){cvt_pk_bf16(kb[8], kb[9]), cvt_pk_bf16(kb[10], kb[11]), cvt_pk_bf16(kb[12], kb[13]), cvt_pk_bf16(kb[14], kb[15])};
      *(MK_LDS u32x4*)(lds + HL_VT + kc * 144 + (16 * sg) * 2) = (u32x4){cvt_pk_bf16(vv[0], vv[1]), cvt_pk_bf16(vv[2], vv[3]), cvt_pk_bf16(vv[4], vv[5]), cvt_pk_bf16(vv[6], vv[7])};
      *(MK_LDS u32x4*)(lds + HL_VT + kc * 144 + (16 * sg + 8) * 2) = (u32x4){cvt_pk_bf16(vv[8], vv[9]), cvt_pk_bf16(vv[10], vv[11]), cvt_pk_bf16(vv[12], vv[13]), cvt_pk_bf16(vv[14], vv[15])};
      if (sg == 0) *(float*)(rec + HC_EC + kc * 4) = __expf(bC); }
    WG_SYNC();
    { const int mi = wave & 3, nh = wave >> 2;
#pragma unroll
      for (int nl = 0; nl < 2; ++nl) { const int ni = 2 * nh + nl; f32x4 at = {0.f, 0.f, 0.f, 0.f};
          if (ni <= mi) {
#pragma unroll
              for (int ks = 0; ks < 4; ++ks) at = mfma16(ldfrag272(lds + HL_KT, ni, ks, ln, q), ldfrag272(lds + HL_QT, mi, ks, ln, q), at); }
          const int t = 16 * mi + ln, s0 = 16 * ni + 4 * q;
          *(MK_LDS u32x2*)(lds + HL_ATT + t * 144 + s0 * 2) = pack4(s0 <= t ? at[0] : 0.f, s0 + 1 <= t ? at[1] : 0.f, s0 + 2 <= t ? at[2] : 0.f, s0 + 3 <= t ? at[3] : 0.f); } }
    WG_SYNC();
    { const int ti = wave & 3, vh = wave >> 2;
      const bf16x8 fa0 = ldfrag(lds + HL_ATT, ti, 0, ln, q), fa1 = ldfrag(lds + HL_ATT, ti, 1, ln, q);
#pragma unroll
      for (int vl = 0; vl < 4; ++vl) { const int vi = 4 * vh + vl; f32x4 o = {0.f, 0.f, 0.f, 0.f};
          o = mfma16(fa0, ldfrag(lds + HL_VT, vi, 0, ln, q), o); o = mfma16(fa1, ldfrag(lds + HL_VT, vi, 1, ln, q), o);
          *(u32x2*)(rec + HC_OI + ((ti * 8 + vi) * 64 + lane) * 8) = pack4(o[0], o[1], o[2], o[3]); }
      const int vi = wave; const bf16x8 fv0 = ldfrag(lds + HL_VT, vi, 0, ln, q), fv1 = ldfrag(lds + HL_VT, vi, 1, ln, q);
#pragma unroll
      for (int ki = 0; ki < 8; ++ki) { f32x4 u = {0.f, 0.f, 0.f, 0.f};
          u = mfma16(ldfrag(lds + HL_KBT, ki, 0, ln, q), fv0, u); u = mfma16(ldfrag(lds + HL_KBT, ki, 1, ln, q), fv1, u);
          *(u32x2*)(rec + HC_UT + ((16 * vi + ln) * 128 + 16 * ki + 4 * q) * 2) = pack4(u[0], u[1], u[2], u[3]); } }
    WG_SYNC();
}
__device__ __forceinline__ void hgrn_chunk_b(const Args& a, int l, int n, int head, int part) {
    const int tid = otid(), v = 16 * part + (tid >> 5), k4 = (tid & 31) * 4;
    unsigned char* rec0 = a.ws + WS_HGC + (size_t)((n * 6 + head) * 32) * HC_BYTES;
    f32x4 S = {0.f, 0.f, 0.f, 0.f};
    for (int c0 = 0; c0 < 32; c0 += 8) {
        f32x4 U[8], E[8];
#pragma unroll
        for (int j = 0; j < 8; ++j) { const unsigned char* rec = rec0 + (size_t)(c0 + j) * HC_BYTES; { const u32x2 uw = *(const u32x2*)(rec + HC_UT + (v * 128 + k4) * 2); U[j] = (f32x4){__uint_as_float(uw.x << 16), __uint_as_float(uw.x & 0xffff0000u), __uint_as_float(uw.y << 16), __uint_as_float(uw.y & 0xffff0000u)}; } E[j] = *(const f32x4*)(rec + HC_EC + k4 * 4); }
#pragma unroll
        for (int j = 0; j < 8; ++j) { unsigned char* rec = rec0 + (size_t)(c0 + j) * HC_BYTES;
            *(u32x2*)(rec + HC_ST + (v * 128 + k4) * 2) = pack4(S[0], S[1], S[2], S[3]);
            S = E[j] * S + U[j]; }
    }
    float* so = a.out + O_HGRN_P + (size_t)((l * 4 + n) * 6 + head) * 16384;
#pragma unroll
    for (int i = 0; i < 4; ++i) so[(size_t)(k4 + i) * 128 + v] = S[i];
}
__device__ __forceinline__ void hgrn_chunk_c(const Args& a, int l, int n, int head, int c, MK_LDS unsigned char* lds) {
    const int tid = otid(), lane = tid & 63, wave = tid >> 6, ln = lane & 15, q = lane >> 4;
    const bf16_t* P = (const bf16_t*)(a.ws + WS_P); bf16_t* MIX = (bf16_t*)(a.ws + WS_MIX);
    const unsigned char* rec = a.ws + WS_HGC + (size_t)((n * 6 + head) * 32 + c) * HC_BYTES;
    const float* hnw = inp(a, I_HNW) + l * 768 + head * 128;
    MK_LDS float* XS = (MK_LDS float*)lds;
    const int ti = wave & 3, vh = wave >> 2, R0 = n * TP + c * 64;
    bf16x8 fq[4];
#pragma unroll
    for (int ks = 0; ks < 4; ++ks) fq[ks] = *(const bf16x8*)(rec + HC_QP + ((16 * ti + ln) * 128 + 32 * ks + 8 * q) * 2);
    f32x4 o[4]; float ssq[4] = {0.f, 0.f, 0.f, 0.f};
#pragma unroll
    for (int vl = 0; vl < 4; ++vl) { const int vi = 4 * vh + vl; { const u32x2 ow = *(const u32x2*)(rec + HC_OI + ((ti * 8 + vi) * 64 + lane) * 8); o[vl] = (f32x4){__uint_as_float(ow.x << 16), __uint_as_float(ow.x & 0xffff0000u), __uint_as_float(ow.y << 16), __uint_as_float(ow.y & 0xffff0000u)}; }
#pragma unroll
        for (int ks = 0; ks < 4; ++ks) o[vl] = mfma16(fq[ks], *(const bf16x8*)(rec + HC_ST + ((16 * vi + ln) * 128 + 32 * ks + 8 * q) * 2), o[vl]);
#pragma unroll
        for (int i = 0; i < 4; ++i) ssq[i] += o[vl][i] * o[vl][i]; }
#pragma unroll
    for (int i = 0; i < 4; ++i) { ssq[i] = row16_sum(ssq[i]); if (ln == 0) XS[vh * 64 + 16 * ti + 4 * q + i] = ssq[i]; }
    WG_SYNC();
#pragma unroll
    for (int i = 0; i < 4; ++i) { const int t = 16 * ti + 4 * q + i; const float rs = rsqrtf((XS[t] + XS[64 + t]) * (1.0f / 128.0f) + 1e-5f);
        const bf16_t* gp = P + (size_t)(R0 + t) * NIN + O_HG + 2304 + head * 128;
#pragma unroll
        for (int vl = 0; vl < 4; ++vl) { const int vv = 16 * (4 * vh + vl) + ln;
            MIX[(size_t)(R0 + t) * D + 1280 + head * 128 + vv] = bf16_1(o[vl][i] * rs * hnw[vv] * silu_f(pbf(gp + vv))); } }
    WG_SYNC();
}
}
namespace mk {
typedef float f32x2 __attribute__((ext_vector_type(2)));
__device__ __forceinline__ void rwkv_sample_wave(const Args& a, int l, int task, MK_LDS float* wl  ) {
    const int lane = otid() & 63, seq = task / 12, head = task % 12, row0 = NPR + seq * 8;
    const float* RWB = (const float*)(a.ws + WS_RW); const float* BON = (const float*)(a.ws + WS_BONUS); bf16_t* MIX = (bf16_t*)(a.ws + WS_MIX);
#pragma unroll
    for (int i = 0; i < 14; ++i) { const int e = lane + 64 * i, step = e / 112, o4 = e - step * 112;
        *(MK_LDS f32x4*)(wl + step * 452 + 4 * o4) = *(const f32x4*)(RWB + ((size_t)(row0 + step) * 12 + head) * 448 + 4 * o4); }
    if (lane < 8) wl[lane * 452 + 448] = BON[(size_t)(row0 + lane) * 12 + head];
    const size_t so = (size_t)((l * 128 + seq) * 12 + head) * 4096 + lane * 64;
    f32x2 S[32];
    { const f32x4* s0 = (const f32x4*)(inp(a, I_WKV) + so);
#pragma unroll
      for (int j = 0; j < 16; ++j) { const f32x4 t = s0[j]; S[2 * j] = t.xy; S[2 * j + 1] = t.zw; } }
    __builtin_amdgcn_wave_barrier(); asm volatile("s_waitcnt lgkmcnt(0)" ::: "memory");
    const int C = head * 64 + lane; const float lw = inp(a, I_LNW)[l * 768 + C], lb = inp(a, I_LNB)[l * 768 + C];
    for (int t = 0; t < 8; ++t) { const MK_LDS float* B = wl + t * 452;
        f32x2 da = {0.f, 0.f}, db = {0.f, 0.f};
#pragma unroll
        for (int j = 0; j < 16; ++j) { const f32x4 kk = *(const MK_LDS f32x4*)(B + 256 + 4 * j); da += S[2 * j] * kk.xy; db += S[2 * j + 1] * kk.zw; }
        const float sa = -((da.x + da.y) + (db.x + db.y)), vv = B[128 + lane];
        const f32x2 sa2 = {sa, sa}, vv2 = {vv, vv};
        f32x2 ya = {0.f, 0.f}, yb = {0.f, 0.f};
#pragma unroll
        for (int j = 0; j < 16; ++j) { const f32x4 dd = *(const MK_LDS f32x4*)(B + 192 + 4 * j), bb = *(const MK_LDS f32x4*)(B + 320 + 4 * j), kv = *(const MK_LDS f32x4*)(B + 64 + 4 * j), rr = *(const MK_LDS f32x4*)(B + 4 * j);
            S[2 * j] = S[2 * j] * dd.xy + (sa2 * bb.xy + vv2 * kv.xy); S[2 * j + 1] = S[2 * j + 1] * dd.zw + (sa2 * bb.zw + vv2 * kv.zw);
            ya += S[2 * j] * rr.xy; yb += S[2 * j + 1] * rr.zw; }
        const float y = (ya.x + ya.y) + (yb.x + yb.y);
        const float mean = wave_sum(y) * (1.0f / 64.0f), dv = y - mean, var = wave_sum(dv * dv) * (1.0f / 64.0f);
        const size_t row = row0 + t; const float gg = B[384 + lane];
        MIX[row * D + 512 + C] = bf16_1((dv * rsqrtf(var + 64e-5f) * lw + lb + B[448] * vv) * gg);
    }
    { f32x4* o = (f32x4*)(a.out + O_WKV_S + so);
#pragma unroll
      for (int j = 0; j < 16; ++j) o[j] = (f32x4){S[2 * j].x, S[2 * j].y, S[2 * j + 1].x, S[2 * j + 1].y}; }
    __builtin_amdgcn_wave_barrier();
}
__device__ __forceinline__ void hgrn_sample_wave(const Args& a, int l, int task, MK_LDS float* wl  ) {
    const int lane = otid() & 63, seq = task / 12, rem = task % 12, head = rem >> 1, col = (rem & 1) * 64 + lane, row0 = NPR + seq * 8;
    const float* P = (const float*)(a.ws + WS_P); float* OHG = (float*)(a.ws + WS_OHG);
#pragma unroll
    for (int i = 0; i < 8; ++i) { const int e = lane + 64 * i, step = e >> 6, o4 = e & 63;
        const float* rp = P + (size_t)(row0 + step) * NIN + O_HG + head * 128;
        *(MK_LDS f32x4*)(wl + step * 320 + 4 * o4) = *(const f32x4*)(o4 < 32 ? rp + 4 * o4 : rp + 768 + 4 * (o4 - 32)); }
#pragma unroll
    for (int t = 0; t < 8; ++t) wl[t * 320 + 256 + lane] = P[(size_t)(row0 + t) * NIN + O_HG + 1536 + head * 128 + col];
    const size_t so = (size_t)((l * 128 + seq) * 6 + head) * 16384 + col;
    f32x2 S[64];
    { const float* s0 = inp(a, I_HGRN) + so;
#pragma unroll
      for (int k = 0; k < 64; ++k) { S[k].x = s0[(size_t)(2 * k) * 128]; S[k].y = s0[(size_t)(2 * k + 1) * 128]; } }
    __builtin_amdgcn_wave_barrier(); asm volatile("s_waitcnt lgkmcnt(0)" ::: "memory");
    for (int t = 0; t < 8; ++t) { const MK_LDS float* B = wl + t * 320;
        const float vv = B[256 + lane];
        const f32x2 vv2 = {vv, vv}; f32x2 oa = {0.f, 0.f}, ob = {0.f, 0.f};
#pragma unroll
        for (int j = 0; j < 32; ++j) { const f32x4 q4 = *(const MK_LDS f32x4*)(B + 4 * j), f4 = *(const MK_LDS f32x4*)(B + 128 + 4 * j);
            S[2 * j] = f4.xy * (S[2 * j] - vv2) + vv2; S[2 * j + 1] = f4.zw * (S[2 * j + 1] - vv2) + vv2;
            oa += q4.xy * S[2 * j]; ob += q4.zw * S[2 * j + 1]; }
        OHG[(size_t)(row0 + t) * 768 + head * 128 + col] = (oa.x + oa.y) + (ob.x + ob.y);
    }
    { float* o = a.out + O_HGRN_S + so;
#pragma unroll
      for (int k = 0; k < 64; ++k) { o[(size_t)(2 * k) * 128] = S[k].x; o[(size_t)(2 * k + 1) * 128] = S[k].y; } }
    __builtin_amdgcn_wave_barrier();
}

constexpr int Q_RWP = 48, Q_HGP = 192, Q_S5 = 1024, Q_SMP = 384, Q_TOTAL = Q_RWP + Q_HGP + Q_S5 + Q_SMP;
__device__ __forceinline__ void phase_scan(const Args& a, int l, MK_LDS unsigned char* lds, int qsel, int skip = 0) {
    const int tid = otid(), wave = tid >> 6;
    unsigned* qhead = (unsigned*)(a.ws + WS_CTL) + CW_Q + 64 * (l + qsel);
    volatile MK_LDS unsigned* qw = (volatile MK_LDS unsigned*)(lds + MISC_OFF + 16);
    const float* P = (const float*)(a.ws + WS_P); const float* RWB = (const float*)(a.ws + WS_RW);
    float* YRW = (float*)(a.ws + WS_YRW); float* OHG = (float*)(a.ws + WS_OHG);
    unsigned nxt = 0u; if (tid == 0) nxt = __hip_atomic_fetch_add(qhead, 1u, __ATOMIC_RELAXED, __HIP_MEMORY_SCOPE_AGENT);
    for (;;) {
        __syncthreads();
        if (tid == 0) qw[0] = nxt;
        __syncthreads();
        int t = (int)qw[0];
        if (t >= Q_TOTAL) break;
        if (tid == 0) nxt = __hip_atomic_fetch_add(qhead, 1u, __ATOMIC_RELAXED, __HIP_MEMORY_SCOPE_AGENT);
        if (t < Q_RWP) { if (!(skip & 1)) rwkv_chunk_b(a, l, t / 12, t % 12, lds); continue; }
        t -= Q_RWP;
        if (t < Q_HGP) { if (!(skip & 2)) hgrn_chunk_b(a, l, t / 48, (t / 8) % 6, t & 7); continue; }
        t -= Q_HGP;
        if (t < Q_S5) { if (!(skip & 4)) s5c_wave(a, l, t * 8 + wave, lds + wave * S5_WAVE_LDS); continue; }
        t -= Q_S5;
        if (!(skip & 8)) { const int wt = t * 8 + wave; if (wt < 1536) rwkv_sample_wave(a, l, wt, (MK_LDS float*)(lds + wave * 14464)); else hgrn_sample_wave(a, l, wt - 1536, (MK_LDS float*)(lds + wave * 14464)); }
    }
    conv_work(a, l + 1, -1, lds);
}
constexpr int Q1_PREP = 96, Q1_RWA = 1536, Q1_HGA = 768, Q1_S5A = 512, Q1_TOTAL = Q1_PREP + Q1_RWA + Q1_HGA + Q1_S5A;
__device__ __forceinline__ void phase_m1(const Args& a, int l, MK_LDS unsigned char* lds) {
    const int tid = otid(), wave = tid >> 6;
    unsigned* qhead = (unsigned*)(a.ws + WS_CTL) + CW_Q + 64 * (l + 8);
    volatile MK_LDS unsigned* qw = (volatile MK_LDS unsigned*)(lds + MISC_OFF + 16);
    unsigned nxt = 0u; if (tid == 0) nxt = __hip_atomic_fetch_add(qhead, 1u, __ATOMIC_RELAXED, __HIP_MEMORY_SCOPE_AGENT);
    for (;;) {
        __syncthreads();
        if (tid == 0) qw[0] = nxt;
        __syncthreads();
        int t = (int)qw[0];
        if (t >= Q1_TOTAL) break;
        if (tid == 0) nxt = __hip_atomic_fetch_add(qhead, 1u, __ATOMIC_RELAXED, __HIP_MEMORY_SCOPE_AGENT);
        if (t < Q1_PREP) { rwkv_prep(a, l, lds, 768 + t, 769 + t); continue; }
        t -= Q1_PREP;
        if (t < Q1_RWA) { rwkv_chunk_a(a, l, t / 384, (t / 32) % 12, t & 31, lds); continue; }
        t -= Q1_RWA;
        if (t < Q1_HGA) { hgrn_chunk_a(a, l, t / 192, (t / 32) % 6, t & 31, lds); continue; }
        t -= Q1_HGA;
        s5a_wave(a, l, t * 8 + wave, lds + wave * S5_WAVE_LDS);
    }
    __syncthreads();
    hgrn_prep(a, l);
}
__device__ __forceinline__ void phase_post(const Args& a, int l) {
    const int tid = otid(), lane = tid & 63, gw = blockIdx.x * 8 + (tid >> 6), nw = gridDim.x * 8;
    const float* P = (const float*)(a.ws + WS_P); const float* RWB = (const float*)(a.ws + WS_RW); const float* BON = (const float*)(a.ws + WS_BONUS);
    const float* YRW = (const float*)(a.ws + WS_YRW); const float* OHG = (const float*)(a.ws + WS_OHG); bf16_t* MIX = (bf16_t*)(a.ws + WS_MIX);
    const float* lnw = inp(a, I_LNW) + l * 768; const float* lnb = inp(a, I_LNB) + l * 768; const float* hnw = inp(a, I_HNW) + l * 768;
    for (int wt = gw; wt < 1024 * 6; wt += nw) { const int row = NPR + wt / 6, head = wt % 6, C = head * 128 + 2 * lane;
        const float2 o = *(const float2*)(OHG + (size_t)row * 768 + C); const float ms = wave_sum(o.x * o.x + o.y * o.y) * (1.0f / 128.0f); const float rs = rsqrtf(ms + 1e-5f);
        const float2 g = *(const float2*)(P + (size_t)row * NIN + O_HG + 2304 + C); const float2 w = *(const float2*)(hnw + C);
        *(unsigned*)(MIX + (size_t)row * D + 1280 + C) = cvt_pk_bf16(o.x * rs * w.x * silu_f(g.x), o.y * rs * w.y * silu_f(g.y)); }
    for (int i = blockIdx.x * 512 + tid; i < 132 * RSW; i += gridDim.x * 512) { const int s = i / RSW, c = i % RSW;
        if (s < 4) a.out[O_SHIFT_P + (size_t)(l * 4 + s) * RSW + c] = pbf((const bf16_t*)P + (size_t)(s * TP + TP - 1) * NIN + O_RW + c);
        else a.out[O_SHIFT_S + (size_t)(l * 128 + (s - 4)) * RSW + c] = P[(size_t)(NPR + (s - 4) * 8 + 7) * NIN + O_RW + c]; }
}
}

using mk::Args;
constexpr int N_PHASES = 1 + mk::NL * 12 + 1;
#ifndef MK_SITES
#define MK_SITES 0xFFFF
#endif
#define SITE(n) ((MK_SITES >> (n)) & 1)
#ifndef MK_REP
#define MK_REP 0
#endif
#define REP(n) ((MK_REP >> (n)) & 1)
__global__ void __launch_bounds__(512, 2) mk_fwd(Args a) {
    extern __shared__ __attribute__((aligned(16))) unsigned char lds_raw[];
    using namespace mk;
    MK_LDS unsigned char* lds = (MK_LDS unsigned char*)lds_raw;
    const int tid = threadIdx.x, G = gridDim.x;
#if MK_NANFILL
    for (int i = tid; i < LDS_BYTES / 4; i += 512) ((MK_LDS unsigned*)lds)[i] = 0u;
    __syncthreads();
#endif
    if (tid < 8) ((MK_LDS unsigned*)(lds + MISC_OFF))[tid] = 0u;
    __syncthreads();
    unsigned* ctl = (unsigned*)(a.ws + WS_CTL);
    XcdBarrier bar; bar.bar = ctl + CW_BAR; bar.x = 0; bar.st = (volatile LAS unsigned*)(lds + MISC_OFF);
#if !MK_PER_PHASE
    bar = xcd_barrier_post(ctl + CW_BAR, (volatile LAS unsigned*)(lds + MISC_OFF));
#endif
    for (int s = 0; s < 5; ++s) {
        const int Ns = s == 0 ? NGU : s == 1 ? D : s == 2 ? NIN : s == 3 ? 512 : D, Ks = s == 0 ? D : s == 1 ? DFF : s == 2 ? D : s == 3 ? 512 : D, km = s == 0 ? 5 : s == 1 ? 8 : s == 2 ? 2 : s == 3 ? 0 : 4;
        (void)pg8::fill_unit_table(NTOK, Ns, Ks, G, (int)blockIdx.x, km, (MK_LDS int*)(lds + MISC_OFF + 64 + s * 512), otid()); }
    const int lo = a.ph_lo, hi = a.ph_hi;
#define IN(k) (lo <= (k) && (k) < hi)
#if MK_PER_PHASE
#define SEAM(k) do { } while (0)
#else
#define SEAM(k) do { if ((k) + 1 < hi) xcd_barrier(bar); } while (0)
#endif
#define X ((bf16_t*)(a.ws + WS_X))
#define HB ((bf16_t*)(a.ws + WS_HB))
#define RSTD ((float*)(a.ws + WS_HB))
#define H ((bf16_t*)(a.ws + WS_H))
#define P ((float*)(a.ws + WS_P))
#define MIX ((bf16_t*)(a.ws + WS_MIX))
#define SKCTX(seq) pg8::SplitCtx{(float*)(a.ws + WS_SK) + (size_t)((seq) & 1) * 256 * 65536, (unsigned*)(a.ws + WS_SKC) + (size_t)(seq) * 96 * 16, (unsigned*)(a.ws + WS_CTL) + 128}
    int ph = 0;
    if (SITE(0) && IN(ph)) { phase_prologue(a, (MK_LDS float*)lds); if (REP(0)) { xcd_barrier(bar); phase_prologue(a, (MK_LDS float*)lds); } SEAM(ph); }
    ++ph;
    for (int l = 0; l < NL; ++l) {
        unsigned char* wl = a.ws + WS_W + (size_t)l * W_LAYER;
        for (int half = 0; half < 2; ++half) {
            if (SITE(1) && IN(ph) && (l | half) != 0) { phase_rstd(X, RSTD); SEAM(ph); }
            ++ph;
            if (SITE(2) && IN(ph)) { pg8::Gemm g{X, (const bf16_t*)(wl + (half ? W_GU2 : W_GU1)), NTOK, NGU, D}; pg8::TabOrder TS; TS.tab = (const MK_LDS int*)(lds + MISC_OFF + 64 + 0 * 512); EpiSwiGLU E{H, RSTD, stage_rstd(TS.tab, RSTD, lds)}; pg8::gemm_phase<EpiSwiGLU, pg8::TabOrder, true, true>(lds, g, TS, E, SKCTX(l * 6 + half * 3 + 0)); if ((int)blockIdx.x >= 5 * ((36 * 44) % G)) conv_work(a, l + 1 + half, 2, lds); SEAM(ph); }
            ++ph;
            if (SITE(3) && IN(ph)) { pg8::Gemm g{H, (const bf16_t*)(wl + (half ? W_DN2 : W_DN1)), NTOK, D, DFF}; EpiResid E{X, 0.5f}; pg8::TabOrder TS; TS.tab = (const MK_LDS int*)(lds + MISC_OFF + 64 + 1 * 512); pg8::gemm_phase<EpiResid, pg8::TabOrder, true, true>(lds, g, TS, E, SKCTX(l * 6 + half * 3 + 1)); if (REP(3)) { xcd_barrier(bar); EpiResid E0{X, 0.0f}; pg8::gemm_phase<EpiResid, pg8::TabOrder, true, true>(lds, g, TS, E0, SKCTX(24 + l * 6 + half * 3 + 1)); } SEAM(ph); }
            ++ph;
            if (half == 0) {
                if (SITE(4) && IN(ph)) { phase_rstd(X, RSTD); SEAM(ph); }
                ++ph;
                if (SITE(5) && IN(ph)) { pg8::Gemm g{X, (const bf16_t*)(wl + W_WIN), NTOK, NIN, D}; pg8::TabOrder TS; TS.tab = (const MK_LDS int*)(lds + MISC_OFF + 64 + 2 * 512); EpiStoreP E{P, NIN, RSTD, stage_rstd(TS.tab, RSTD, lds)}; pg8::gemm_phase<EpiStoreP, pg8::TabOrder, true, true>(lds, g, TS, E, SKCTX(l * 6 + 2)); if ((int)blockIdx.x >= 2 * ((36 * 24) % G)) conv_work(a, l + 1, 2, lds); SEAM(ph); }
                ++ph;
                if (SITE(6) && IN(ph)) { phase_m1(a, l, lds); SEAM(ph); }
                ++ph;
                if (SITE(7) && IN(ph)) { phase_scan(a, l, lds, 0); if (REP(7)) { xcd_barrier(bar); phase_scan(a, l, lds, 4, MK_QSKIP); } SEAM(ph); }
                ++ph;
                if (SITE(8) && IN(ph)) {
                    pg8::Gemm g{(const bf16_t*)(a.ws + WS_YS5B), (const bf16_t*)(wl + W_GLU), NTOK, 512, 512}; EpiGLU E{(const bf16_t*)(a.ws + WS_YS5B), inp(a, I_BGLU) + l * 512, MIX}; pg8::TabOrder TS; TS.tab = (const MK_LDS int*)(lds + MISC_OFF + 64 + 3 * 512); pg8::gemm_phase<EpiGLU, pg8::TabOrder, true, true>(lds, g, TS, E);
                    for (int rep = 0; rep < 1 + REP(8); ++rep) {
                    __syncthreads();
                    for (int task = blockIdx.x; task < 768; task += G) hgrn_chunk_c(a, l, task / 192, (task / 32) % 6, task & 31, lds);
                    for (int wt = blockIdx.x * 8 + (otid() >> 6); wt < 6144; wt += G * 8) rwkv_chunk_c_wave(a, l, wt);
                    phase_post(a, l);
                    }
                    SEAM(ph); }
                ++ph;
                if (SITE(9) && IN(ph)) { pg8::Gemm g{MIX, (const bf16_t*)(wl + W_WOUT), NTOK, D, D}; EpiResid E{X, 1.0f}; pg8::TabOrder TS; TS.tab = (const MK_LDS int*)(lds + MISC_OFF + 64 + 4 * 512); pg8::gemm_phase<EpiResid, pg8::TabOrder, true, true>(lds, g, TS, E, SKCTX(l * 6 + 5)); if ((int)blockIdx.x >= 4 * ((36 * 8) % G)) conv_work(a, l + 2, 2, lds); SEAM(ph); }
                ++ph;
            }
        }
    }
    if (SITE(10) && IN(ph)) phase_rmsnorm(X, inp(a, I_NORMF), nullptr, a.out + O_YP);
#undef IN
#undef SEAM
#undef X
#undef HB
#undef H
#undef P
#undef MIX
}

extern "C" void kernel_launch(void* const* d_in, const int* in_sizes, int n_in, void* d_out, int out_size, void* d_ws, size_t ws_size, hipStream_t stream) {
    using namespace mk;
    static int grid = 0;
    if (grid == 0) {
        if (n_in != N_IN || (size_t)out_size != O_END || ws_size < WS_END) { fprintf(stderr, "kernel_launch: unexpected shapes: n_in %d out %d ws %zu (need %zu)\n", n_in, out_size, ws_size, (size_t)WS_END); grid = -1; return; }
        int dev = 0, cus = 0, per_cu = 0;
        if (hipGetDevice(&dev) != hipSuccess || hipDeviceGetAttribute(&cus, hipDeviceAttributeMultiprocessorCount, dev) != hipSuccess) { grid = -1; return; }
        if (hipFuncSetAttribute((const void*)mk_fwd, hipFuncAttributeMaxDynamicSharedMemorySize, LDS_BYTES) != hipSuccess) { fprintf(stderr, "kernel_launch: hipFuncSetAttribute failed\n"); grid = -1; return; }
        if (hipOccupancyMaxActiveBlocksPerMultiprocessor(&per_cu, (const void*)mk_fwd, 512, LDS_BYTES) != hipSuccess || per_cu < 1) { fprintf(stderr, "kernel_launch: occupancy query says %d\n", per_cu); (void)hipGetLastError(); }
        grid = cus;
    }
    if (grid < 0) return;
    (void)in_sizes;
    if (hipMemsetAsync((char*)d_ws + WS_CTL, 0, CTL_BYTES, stream) != hipSuccess) return;
    if (hipMemsetAsync((char*)d_ws + WS_SKC, 0, SKC_BYTES, stream) != hipSuccess) return;
#if MK_NANFILL
    (void)hipMemsetAsync((char*)d_ws + WS_X, 0x00, WS_W - WS_X, stream);
#endif
    Args a{};
    for (int i = 0; i < N_IN; ++i) a.in[i] = (const float*)d_in[i];
    a.out = (float*)d_out; a.ws = (unsigned char*)d_ws;
#if MK_PER_PHASE
    for (int p = 0; p < N_PHASES; ++p) { a.ph_lo = p; a.ph_hi = p + 1; hipLaunchKernelGGL(mk_fwd, dim3(grid), dim3(512), LDS_BYTES, stream, a); }
#else
    a.ph_lo = 0; a.ph_hi = N_PHASES; hipLaunchKernelGGL(mk_fwd, dim3(grid), dim3(512), LDS_BYTES, stream, a);
#endif
    const hipError_t le = hipPeekAtLastError();
    if (le != hipSuccess) fprintf(stderr, "kernel_launch: launch failed: %s\n", hipGetErrorName(le));
}
```

```cpp
#include <hip/hip_runtime.h>
#include <cstdio>
#include <cstdint>

#ifndef MK_PER_PHASE
#define MK_PER_PHASE 0
#define MK_REP 0
#define MK_NANFILL 0
#ifndef MK_QSKIP
#define MK_QSKIP 0
#endif
#endif
namespace pg8 {
#define PG8_LAS __attribute__((address_space(3)))
typedef unsigned short bf16_t;
typedef short bf16x8 __attribute__((ext_vector_type(8)));
typedef float f32x4 __attribute__((ext_vector_type(4)));
typedef unsigned u32x4 __attribute__((ext_vector_type(4)));
constexpr int BM = 256, BK = 64, HALF = 128, HTB = HALF * BK * 2  , STAGE_BYTES = 8 * HTB, NXCD = 8, WGM = 8;

__host__ __device__ __forceinline__ int lds_byte(int r, int c) { const int st = (r >> 4) * 2 + (c >> 5), rr = r & 15, cc = c & 31, ob = rr * 64 + cc * 2; return st * 1024 + (ob ^ (((ob >> 9) & 1) << 5)); }
__host__ __device__ __forceinline__ void stage_rc(int b, int& R, int& C) { const int st = b / 1024, sb = b % 1024, swz = sb ^ (((sb >> 9) & 1) << 5); R = (st >> 1) * 16 + swz / 64; C = (st & 1) * 32 + (swz % 64) / 2; }
__host__ __device__ __forceinline__ int perm32(int rho) { const int n = rho >> 4, i = rho & 15; return 8 * (i >> 2) + 4 * n + (i & 3); }

struct Unit { int pm, pn; int kt0, nkt, part, nparts, slot; };
struct Gemm { const bf16_t* A; const bf16_t* Bt; int M, N, K; };

struct StaticOrder {
    int nM, nN, nwg, G, c, nktf;
    __host__ __device__ void init(int M, int N, int K, int G_, int c_) { nM = M / BM; nN = N / BM; nwg = nM * nN; G = G_; c = c_; nktf = K / BK; }
    __host__ __device__ void tile_of(int L, Unit& u) const {
        int wgid = L; { const int q = nwg / NXCD, r = nwg % NXCD, xcd = wgid % NXCD, off = wgid / NXCD; wgid = (xcd < r ? xcd * (q + 1) : r * (q + 1) + (xcd - r) * q) + off; }
        const int nig = WGM * nN, gid = wgid / nig, fm = gid * WGM, gsz = (nM - fm) < WGM ? (nM - fm) : WGM;
        u.pm = fm + ((wgid % nig) % gsz); u.pn = (wgid % nig) / gsz; }
    __host__ __device__ bool next(int i, Unit& u) const {
        const long L = (long)i * G + c; if (L >= nwg) return false;
        tile_of((int)L, u); u.kt0 = 0; u.nkt = nktf; u.part = -1; u.nparts = 1; u.slot = 0; return true;
    }
    __device__ __forceinline__ void a_ready(const Unit&) const {}
    __device__ __forceinline__ void done(const Unit&) const {}
};
struct SplitOrder : StaticOrder {
    __host__ __device__ bool unit_of(int i, Unit& u, int kmax) const {
        const int rounds = nwg / G, r = nwg % G; u.kt0 = 0; u.nkt = nktf; u.part = -1; u.nparts = 1; u.slot = 0; u.pm = 0; u.pn = 0;
        if (i < rounds) { tile_of(i * G + c, u); return true; }
        if (i > rounds || r == 0) return false;
        int k = G / r; const int ntg = nktf / 4; if (k > ntg) k = ntg; if (k > kmax) k = kmax;
        if (c >= r * k) return false;
        const int U = c / k, j = c % k, g0 = (j * ntg) / k, g1 = ((j + 1) * ntg) / k;
        tile_of(rounds * G + U, u); u.kt0 = 4 * g0; u.nkt = 4 * (g1 - g0); u.part = (k > 1) ? j : -1; u.nparts = k; u.slot = U * k; return true;
    }
};
typedef __bf16 bf16x2_t __attribute__((ext_vector_type(2)));
typedef float f32x2_t __attribute__((ext_vector_type(2)));
__device__ __forceinline__ unsigned cvt_pk_bf16(float lo, float hi) { const f32x2_t v = {lo, hi}; const bf16x2_t r = __builtin_convertvector(v, bf16x2_t); return __builtin_bit_cast(unsigned, r); }
struct TabOrder {
    const PG8_LAS int* tab;
    __device__ __forceinline__ bool next(int i, Unit& u) const {
        if (i >= 16 || __builtin_amdgcn_readfirstlane(tab[8 * i + 7]) == 0) return false;
        u.pm = __builtin_amdgcn_readfirstlane(tab[8 * i]); u.pn = __builtin_amdgcn_readfirstlane(tab[8 * i + 1]); u.kt0 = __builtin_amdgcn_readfirstlane(tab[8 * i + 2]); u.nkt = __builtin_amdgcn_readfirstlane(tab[8 * i + 3]);
        u.part = __builtin_amdgcn_readfirstlane(tab[8 * i + 4]); u.nparts = __builtin_amdgcn_readfirstlane(tab[8 * i + 5]); u.slot = __builtin_amdgcn_readfirstlane(tab[8 * i + 6]); return true;
    }
    __device__ __forceinline__ void a_ready(const Unit&) const {}
    __device__ __forceinline__ void done(const Unit&) const {}
};
__device__ __forceinline__ TabOrder fill_unit_table(int M, int N, int K, int G, int c, int kmax  , PG8_LAS int* tabw, int tid) {
    if (tid < 16) { SplitOrder S; S.init(M, N, K, G, c); Unit u; bool ok;
        if (kmax > 1) ok = S.unit_of(tid, u, kmax); else ok = S.next(tid, u);
        tabw[8 * tid] = u.pm; tabw[8 * tid + 1] = u.pn; tabw[8 * tid + 2] = u.kt0; tabw[8 * tid + 3] = u.nkt; tabw[8 * tid + 4] = u.part; tabw[8 * tid + 5] = u.nparts; tabw[8 * tid + 6] = (ok && u.part < 0) ? tid : u.slot;        tabw[8 * tid + 7] = ok ? 1 : 0; }
    __syncthreads();
    TabOrder T; T.tab = tabw; return T;
}
struct SplitCtx { float* slots; unsigned* cnt; unsigned* tmo; };
template <class Epi, class Sched, bool ALIGN_EPI = false, bool SP2 = false>
__device__ __forceinline__ void gemm_phase(PG8_LAS unsigned char* lds, const Gemm g, const Sched& S, const Epi& E, const SplitCtx sk = SplitCtx{nullptr, nullptr, nullptr}) {
    int tid_ = threadIdx.x; asm volatile("" : "+v"(tid_));
    const int tid = tid_, wid = __builtin_amdgcn_readfirstlane(tid >> 6), lane = tid & 63, wr = wid >> 2, wc = wid & 3, fr = lane & 15, fq = lane >> 4;
    const int K = g.K;
    unsigned voffA[2], voffB[2];
#pragma unroll
    for (int i = 0; i < 2; ++i) { int R, C; stage_rc(tid * 16 + i * 8192, R, C); const int Rb = Epi::PERM ? ((R & ~31) + perm32(R & 31)) : R;
        voffA[i] = (unsigned)(R * K + C) * 2u; voffB[i] = (unsigned)(Rb * K + C) * 2u; }
    const size_t kstep = (size_t)(BK * 2);
    const size_t hstep = (size_t)HALF * K * 2;
    const size_t tstep = 2 * hstep;
    const unsigned ldsw = (unsigned)wid * 1024u;
    const int aoff = lds_byte(wr * 64 + fr, fq * 8), boff = lds_byte(wc * 32 + fr, fq * 8);
#define PG8_SA(b, h) (((b) * 2 + (h)) * HTB)
#define PG8_SB(b, h) ((4 + (b) * 2 + (h)) * HTB)
#define PG8_STAGE(bufoff, gbase, voff) do { _Pragma("unroll") for (int _i = 0; _i < 2; ++_i) \
        __builtin_amdgcn_global_load_lds((const unsigned*)((const char*)(gbase) + (voff)[_i]), (PG8_LAS unsigned*)(lds + (bufoff) + ldsw + _i * 8192), 16, 0, 0); } while (0)
#define PG8_LDA(dst, b, h) do { _Pragma("unroll") for (int m = 0; m < 4; ++m) _Pragma("unroll") for (int k = 0; k < 2; ++k) dst[m][k] = *(const PG8_LAS bf16x8*)(lds + PG8_SA(b, h) + aoff + m * 2048 + k * 1024); } while (0)
#define PG8_LDB(dst, b, h) do { _Pragma("unroll") for (int n = 0; n < 2; ++n) _Pragma("unroll") for (int k = 0; k < 2; ++k) dst[n][k] = *(const PG8_LAS bf16x8*)(lds + PG8_SB(b, h) + boff + n * 2048 + k * 1024); } while (0)
#define PG8_MMA(ai, bj, At, Bt) do { __builtin_amdgcn_s_setprio(1); _Pragma("unroll") for (int m = 0; m < 4; ++m) _Pragma("unroll") for (int n = 0; n < 2; ++n) _Pragma("unroll") for (int k = 0; k < 2; ++k) \
        acc[ai][bj][m][n] = __builtin_amdgcn_mfma_f32_16x16x32_bf16(Bt[n][k], At[m][k], acc[ai][bj][m][n], 0, 0, 0); __builtin_amdgcn_s_setprio(0); } while (0)
#define PG8_WAIT_V(n) asm volatile("s_waitcnt vmcnt(" #n ")" ::: "memory")
#define PG8_WAIT_L(n) asm volatile("s_waitcnt lgkmcnt(" #n ")" ::: "memory")
#define PG8_BAR __builtin_amdgcn_s_barrier()
#define PG8_SCHED __builtin_amdgcn_sched_barrier(0)
    Unit cur, nxt; int ui = 0;
    if (!S.next(0, cur)) return;
    f32x4 acc[2][2][4][2];
#pragma unroll
    for (int a = 0; a < 2; ++a)
#pragma unroll
        for (int b = 0; b < 2; ++b)
#pragma unroll
            for (int m = 0; m < 4; ++m)
#pragma unroll
                for (int n = 0; n < 2; ++n) acc[a][b][m][n] = (f32x4){0.f, 0.f, 0.f, 0.f};
    bf16x8 At[4][2], B0[2][2], B1[2][2];
    const char* cA = (const char*)g.A + (size_t)cur.pm * tstep + (size_t)cur.kt0 * kstep; const char* cB = (const char*)g.Bt + (size_t)cur.pn * tstep + (size_t)cur.kt0 * kstep;
    S.a_ready(cur);
    if constexpr (SP2) {
        PG8_STAGE(PG8_SB(0, 0), cB, voffB); PG8_STAGE(PG8_SB(0, 1), cB + hstep, voffB); PG8_STAGE(PG8_SA(0, 0), cA, voffA); PG8_STAGE(PG8_SA(0, 1), cA + hstep, voffA);
        if (wr == 1) PG8_BAR;
        PG8_WAIT_V(2); PG8_BAR;
        PG8_STAGE(PG8_SB(1, 0), cB + kstep, voffB); PG8_STAGE(PG8_SA(1, 0), cA + kstep, voffA); PG8_STAGE(PG8_SB(1, 1), cB + hstep + kstep, voffB);
        PG8_WAIT_V(6); PG8_BAR;
    } else {
        PG8_STAGE(PG8_SB(0, 0), cB, voffB); PG8_STAGE(PG8_SA(0, 0), cA, voffA); PG8_STAGE(PG8_SB(0, 1), cB + hstep, voffB); PG8_STAGE(PG8_SA(0, 1), cA + hstep, voffA);
        if (wr == 1) PG8_BAR;
        PG8_WAIT_V(4); PG8_BAR;
        PG8_STAGE(PG8_SB(1, 0), cB + kstep, voffB); PG8_STAGE(PG8_SA(1, 0), cA + kstep, voffA); PG8_STAGE(PG8_SB(1, 1), cB + hstep + kstep, voffB);
        PG8_WAIT_V(6); PG8_BAR;
    }
    for (;;) {
        const bool has_next = S.next(ui + 1, nxt);
        const char* nA = has_next ? (const char*)g.A + (size_t)nxt.pm * tstep + (size_t)nxt.kt0 * kstep : cA; const char* nB = has_next ? (const char*)g.Bt + (size_t)nxt.pn * tstep + (size_t)nxt.kt0 * kstep : cB;
        const int nt = cur.nkt;
        for (int t = 0; t < nt; t += 2) {
            const bool last = (t == nt - 2);
            const char* a1 = cA + (size_t)(t + 1) * kstep;
            const char* a2 = last ? nA : cA + (size_t)(t + 2) * kstep; const char* b2 = last ? nB : cB + (size_t)(t + 2) * kstep;
            const char* a3 = a2 + kstep; const char* b3 = b2 + kstep;
            if (last && has_next) S.a_ready(nxt);
            if constexpr (SP2) {
            PG8_LDB(B0, 0, 0); PG8_LDB(B1, 0, 1); PG8_SCHED; PG8_LDA(At, 0, 0); PG8_STAGE(PG8_SA(1, 1), a1 + hstep, voffA);
            PG8_WAIT_V(8); PG8_WAIT_L(0); PG8_BAR; PG8_MMA(0, 0, At, B0); PG8_MMA(0, 1, At, B1); PG8_BAR; PG8_SCHED;
            PG8_LDA(At, 0, 1); PG8_STAGE(PG8_SB(0, 0), b2, voffB); PG8_STAGE(PG8_SB(0, 1), b2 + hstep, voffB); PG8_STAGE(PG8_SA(0, 0), a2, voffA);
            PG8_WAIT_V(8); PG8_WAIT_L(0); PG8_BAR; PG8_MMA(1, 0, At, B0); PG8_MMA(1, 1, At, B1); PG8_BAR; PG8_SCHED;
            PG8_LDB(B0, 1, 0); PG8_LDB(B1, 1, 1); PG8_SCHED; PG8_LDA(At, 1, 0); PG8_STAGE(PG8_SA(0, 1), a2 + hstep, voffA);
            PG8_WAIT_V(8); PG8_WAIT_L(0); PG8_BAR; PG8_MMA(0, 0, At, B0); PG8_MMA(0, 1, At, B1); PG8_BAR; PG8_SCHED;
            PG8_LDA(At, 1, 1); PG8_STAGE(PG8_SB(1, 0), b3, voffB); PG8_STAGE(PG8_SB(1, 1), b3 + hstep, voffB); PG8_STAGE(PG8_SA(1, 0), a3, voffA);
            PG8_WAIT_V(8); PG8_WAIT_L(0); PG8_BAR; PG8_MMA(1, 0, At, B0); PG8_MMA(1, 1, At, B1); PG8_BAR; PG8_SCHED;
            } else {
            PG8_LDB(B0, 0, 0); PG8_SCHED; PG8_LDA(At, 0, 0); PG8_STAGE(PG8_SA(1, 1), a1 + hstep, voffA);
            PG8_WAIT_L(8); PG8_BAR; PG8_WAIT_L(0); PG8_MMA(0, 0, At, B0); PG8_BAR; PG8_SCHED;
            PG8_LDB(B1, 0, 1); PG8_STAGE(PG8_SB(0, 0), b2, voffB);
            PG8_BAR; PG8_WAIT_L(0); PG8_MMA(0, 1, At, B1); PG8_BAR;
            PG8_LDA(At, 0, 1); PG8_STAGE(PG8_SA(0, 0), a2, voffA);
            PG8_BAR; PG8_WAIT_L(0); PG8_MMA(1, 0, At, B0); PG8_BAR; PG8_SCHED;
            PG8_STAGE(PG8_SB(0, 1), b2 + hstep, voffB);
            PG8_WAIT_V(6); PG8_BAR; PG8_MMA(1, 1, At, B1); PG8_BAR;
            PG8_LDB(B0, 1, 0); PG8_SCHED; PG8_LDA(At, 1, 0); PG8_STAGE(PG8_SA(0, 1), a2 + hstep, voffA);
            PG8_WAIT_L(8); PG8_BAR; PG8_WAIT_L(0); PG8_MMA(0, 0, At, B0); PG8_BAR; PG8_SCHED;
            PG8_LDB(B1, 1, 1); PG8_STAGE(PG8_SB(1, 0), b3, voffB);
            PG8_BAR; PG8_WAIT_L(0); PG8_MMA(0, 1, At, B1); PG8_BAR;
            PG8_LDA(At, 1, 1); PG8_STAGE(PG8_SA(1, 0), a3, voffA);
            PG8_BAR; PG8_WAIT_L(0); PG8_MMA(1, 0, At, B0); PG8_BAR; PG8_SCHED;
            PG8_STAGE(PG8_SB(1, 1), b3 + hstep, voffB);
            PG8_WAIT_V(6); PG8_BAR; PG8_MMA(1, 1, At, B1); PG8_BAR;
            }
        }
        if constexpr (ALIGN_EPI) { if (wr == 0) PG8_BAR; }
        if constexpr (!Epi::AFTER_DRAIN) { if (cur.part < 0) { E(acc, cur, wr, wc, fr, fq); S.done(cur); } }
        if (!has_next) break;
#pragma unroll
        for (int a = 0; a < 2; ++a)
#pragma unroll
            for (int b = 0; b < 2; ++b)
#pragma unroll
                for (int m = 0; m < 4; ++m)
#pragma unroll
                    for (int n = 0; n < 2; ++n) acc[a][b][m][n] = (f32x4){0.f, 0.f, 0.f, 0.f};
        cur = nxt; cA = nA; cB = nB; ++ui;
        if constexpr (ALIGN_EPI) { if (wr == 1) PG8_BAR; }
    }
    PG8_WAIT_V(0);
    if constexpr (!ALIGN_EPI) { if (wr == 0) PG8_BAR; }
    PG8_BAR;
    if constexpr (!Epi::AFTER_DRAIN) { if (cur.part >= 0) {
        float* myslot = sk.slots + (size_t)(cur.slot + cur.part) * 65536;
        const __amdgpu_buffer_rsrc_t rs = __builtin_amdgcn_make_buffer_rsrc(myslot, 0, 131072, 0x00020000);
#pragma unroll
        for (int ai = 0; ai < 2; ++ai)
#pragma unroll
            for (int bj = 0; bj < 2; ++bj)
#pragma unroll
                for (int m = 0; m < 4; ++m) { const f32x4 a0 = acc[ai][bj][m][0], a1 = acc[ai][bj][m][1];
                    u32x4 w; w.x = cvt_pk_bf16(a0[0], a0[1]); w.y = cvt_pk_bf16(a0[2], a0[3]); w.z = cvt_pk_bf16(a1[0], a1[1]); w.w = cvt_pk_bf16(a1[2], a1[3]);
                    __builtin_amdgcn_raw_buffer_store_b128(w, rs, ((((ai * 2 + bj) * 4 + m)) * 512 + tid) * 16, 0, 16); }
        asm volatile("s_waitcnt vmcnt(0)" ::: "memory");
        __syncthreads();
        unsigned* cw = sk.cnt + 16 * (cur.slot / cur.nparts);
        if (tid == 0) {
            __hip_atomic_fetch_add(cw, 1u, __ATOMIC_RELAXED, __HIP_MEMORY_SCOPE_AGENT);
            unsigned sp = 0;
            while (__hip_atomic_load(cw, __ATOMIC_RELAXED, __HIP_MEMORY_SCOPE_AGENT) < (unsigned)cur.nparts) { __builtin_amdgcn_s_sleep(2);
                if ((++sp & 1023u) == 0u) { if (__hip_atomic_load(sk.tmo, __ATOMIC_RELAXED, __HIP_MEMORY_SCOPE_AGENT)) break; if (sp > (1u << 24)) { __hip_atomic_store(sk.tmo, 1u, __ATOMIC_RELAXED, __HIP_MEMORY_SCOPE_AGENT); break; } } }
            __builtin_amdgcn_fence(__ATOMIC_ACQUIRE, "agent");
            asm volatile("s_waitcnt vmcnt(0)" ::: "memory");
        }
        __syncthreads();
        const int g0 = (8 * cur.part) / cur.nparts, g1 = (8 * (cur.part + 1)) / cur.nparts;
        for (int gq = g0; gq < g1; ++gq) { const int ai = gq >> 2, m = gq & 3;
            f32x4 v[2][2] = {{{0.f, 0.f, 0.f, 0.f}, {0.f, 0.f, 0.f, 0.f}}, {{0.f, 0.f, 0.f, 0.f}, {0.f, 0.f, 0.f, 0.f}}};
#pragma unroll
            for (int ph = 0; ph < 2; ++ph) { if (4 * ph < cur.nparts) {
                u32x4 pw[4][2];
#pragma unroll
                for (int pp = 0; pp < 4; ++pp)
#pragma unroll
                    for (int bj = 0; bj < 2; ++bj) { const int p = 4 * ph + pp; pw[pp][bj] = (u32x4){0u, 0u, 0u, 0u};
                        if (p < cur.nparts) pw[pp][bj] = *(const u32x4*)((const char*)(sk.slots + (size_t)(cur.slot + p) * 65536) + (size_t)(((ai * 2 + bj) * 4 + m) * 512 + tid) * 16); }
#pragma unroll
                for (int pp = 0; pp < 4; ++pp)
#pragma unroll
                    for (int bj = 0; bj < 2; ++bj) { const u32x4 w = pw[pp][bj];
                        v[bj][0] += (f32x4){__uint_as_float(w.x << 16), __uint_as_float(w.x & 0xffff0000u), __uint_as_float(w.y << 16), __uint_as_float(w.y & 0xffff0000u)};
                        v[bj][1] += (f32x4){__uint_as_float(w.z << 16), __uint_as_float(w.z & 0xffff0000u), __uint_as_float(w.w << 16), __uint_as_float(w.w & 0xffff0000u)}; } } }
            E.group(v, cur, ai, m, wr, wc, fr, fq); }
    } }
    if constexpr (Epi::AFTER_DRAIN) { E.fused(acc, cur, wr, wc, fr, fq, lds, wid, lane); S.done(cur); }
#undef PG8_SA
#undef PG8_SB
#undef PG8_STAGE
#undef PG8_LDA
#undef PG8_LDB
#undef PG8_MMA
#undef PG8_WAIT_V
#undef PG8_WAIT_L
#undef PG8_BAR
#undef PG8_SCHED
}
}
#define XB_TMO      128
#define XB_XCNT(j)  (256  + 64 * (j))
#define XB_XSUB(j)  (1280 + 64 * (j))
#define XB_XGEN(j)  (2304 + 64 * (j))
#define XB_TOP      3328
#define XB_TOPGEN   3392
#define XCD_BAR_WORDS 3456
#define XB_SPIN_CAP (1u << 24)
#define LAS __attribute__((address_space(3)))

__device__ __forceinline__ unsigned xb_ld(unsigned* p)              { return __hip_atomic_load(p, __ATOMIC_RELAXED, __HIP_MEMORY_SCOPE_AGENT); }
__device__ __forceinline__ unsigned xb_add(unsigned* p, unsigned v) { return __hip_atomic_fetch_add(p, v, __ATOMIC_RELAXED, __HIP_MEMORY_SCOPE_AGENT); }
__device__ __forceinline__ unsigned xb_xcc_id() { return (unsigned)__builtin_amdgcn_s_getreg((3 << 11) | 20) & 0xFu; }
#define XB_SPIN(cond, bar) do { unsigned _sp = 0; while (cond) { __builtin_amdgcn_s_sleep(1); \
    if ((++_sp & 255u) == 0u) { if (xb_ld(&(bar)[XB_TMO])) break; if (_sp > XB_SPIN_CAP) { atomicAdd(&(bar)[XB_TMO], 1u); break; } } } } while (0)

struct XcdBarrier {
    unsigned* bar; unsigned x;
    volatile LAS unsigned* st;
};

__device__ __forceinline__ XcdBarrier xcd_barrier_post(unsigned* bar, volatile LAS unsigned* st) {
    XcdBarrier b; b.bar = bar; b.x = xb_xcc_id(); b.st = st;
    if (threadIdx.x == 0) (void)xb_add(&bar[XB_XCNT(b.x)], 1u);
    return b;
}
__device__ __forceinline__ void xcd_barrier_complete(unsigned* bar, unsigned x, unsigned& nloc, unsigned& nx) {
    const unsigned G = gridDim.x * gridDim.y * gridDim.z;
    unsigned sum, cnt, mine, sp = 0u;
    for (;;) {
        sum = 0u; cnt = 0u; mine = 0u;
#pragma unroll
        for (unsigned j = 0; j < 16; ++j) { const unsigned c = xb_ld(&bar[XB_XCNT(j)]); sum += c; cnt += (c > 0u) ? 1u : 0u; mine = (j == x) ? c : mine; }
        if (sum == G) break;
        __builtin_amdgcn_s_sleep(1);
        if ((++sp & 255u) == 0u) { if (xb_ld(&bar[XB_TMO])) break; if (sp > XB_SPIN_CAP) { atomicAdd(&bar[XB_TMO], 1u); break; } }
    }
    nloc = mine > 0u ? mine : 1u; nx = cnt > 0u ? cnt : 1u;
}

__device__ __forceinline__ void xcd_barrier(const XcdBarrier& b) {
    asm volatile("s_waitcnt vmcnt(0)" ::: "memory");
    __syncthreads();
    if (threadIdx.x == 0) {
        unsigned* bar = b.bar;
        __builtin_amdgcn_s_waitcnt(0);
        unsigned nloc = b.st[0], nx = b.st[1];
        if (nloc == 0u) { xcd_barrier_complete(bar, b.x, nloc, nx); b.st[0] = nloc; b.st[1] = nx; }
        const unsigned old = xb_add(&bar[XB_XSUB(b.x)], 1u);
        const unsigned gen = old / nloc;
        if (old + 1u == (gen + 1u) * nloc) {
            __builtin_amdgcn_fence(__ATOMIC_RELEASE, "agent");
            asm volatile("s_waitcnt vmcnt(0)" ::: "memory");
            const unsigned og = xb_add(&bar[XB_TOP], 1u);
            const unsigned tg = og / nx;
            if (og + 1u == (tg + 1u) * nx) xb_add(&bar[XB_TOPGEN], 1u);
            else XB_SPIN(xb_ld(&bar[XB_TOPGEN]) == tg, bar);
            __builtin_amdgcn_fence(__ATOMIC_ACQUIRE, "agent");
            xb_add(&bar[XB_XGEN(b.x)], 1u);
            asm volatile("s_waitcnt vmcnt(0)" ::: "memory");
        } else {
            XB_SPIN(xb_ld(&bar[XB_XGEN(b.x)]) == gen, bar);
            __builtin_amdgcn_fence(__ATOMIC_ACQUIRE, "agent");
            asm volatile("s_waitcnt vmcnt(0)" ::: "memory");
        }
    }
    __syncthreads();
}


namespace mk {
using pg8::bf16_t; using pg8::bf16x8; using pg8::f32x4; using pg8::u32x4; using pg8::cvt_pk_bf16;
#define MK_LDS __attribute__((address_space(3)))
typedef unsigned u32x2 __attribute__((ext_vector_type(2)));

constexpr int D = 2048, NTOK = 9216, NPR = 8192, DFF = 5632, NGU = 11264, NIN = 6144, NL = 4;
constexpr int TP = 2048, BS = 128, TS = 8;
constexpr int O_RW = 512, O_HG = 3072, RSW = 2560;
constexpr float NORM_EPS = 1e-6f;

enum { I_XP = 0, I_XS, I_S5RE, I_S5IM, I_SHIFT, I_WKV, I_HGRN, I_NORM1, I_G1, I_U1, I_D1, I_NORMM, I_WIN, I_AARE, I_AAIM, I_LOGDT, I_BRE, I_BIM, I_CRE, I_CIM, I_S5D, I_WGLU, I_BGLU,
       I_MU, I_W0, I_W2, I_A0, I_A2, I_G2, I_KK, I_KA, I_RK, I_LNW, I_LNB, I_LBRAW, I_HNW, I_WOUT, I_NORM2, I_G2F, I_U2F, I_D2F, I_NORMF, N_IN };
constexpr size_t O_YP = 0, O_YS = 16777216, O_S5RE_P = 18874368, O_S5IM_P = 18907136, O_SHIFT_P = 18939904, O_WKV_P = 18980864, O_HGRN_P = 19767296,
                 O_S5RE_S = 21340160, O_S5IM_S = 22388736, O_SHIFT_S = 23437312, O_WKV_S = 24748032, O_HGRN_S = 49913856, O_END = 100245504;
constexpr size_t WS_CTL = 0, CTL_BYTES = 65536;
constexpr size_t WS_X = WS_CTL + CTL_BYTES;
constexpr size_t WS_HB = WS_X + (size_t)NTOK * D * 4;
constexpr size_t WS_H = WS_HB + (size_t)NTOK * D * 2;
constexpr size_t WS_P = WS_H + (size_t)NTOK * DFF * 2;
constexpr size_t WS_RW = WS_P + (size_t)NTOK * NIN * 4;
constexpr size_t WS_HGC = WS_RW;
constexpr size_t WS_YRW = WS_RW + (size_t)NTOK * 12 * 448 * 4;
constexpr size_t WS_OHG = WS_YRW + (size_t)NTOK * 768 * 4;
constexpr size_t WS_YS5 = WS_OHG + (size_t)NTOK * 768 * 4;
constexpr size_t WS_YS5B = WS_YS5 + (size_t)NTOK * 512 * 4;
constexpr size_t WS_MIX = WS_YS5B + (size_t)NTOK * 512 * 2;
constexpr size_t WS_S5E = WS_MIX + (size_t)NTOK * D * 2;
constexpr size_t WS_BONUS = WS_S5E + (size_t)4 * 32 * 32 * 128 * 4;
constexpr size_t WS_RWC = (WS_BONUS + (size_t)NTOK * 12 * 4 + 255) & ~(size_t)255;
constexpr size_t WS_W = WS_RWC + (size_t)1536 * 98816;
constexpr size_t W_GU1 = 0, W_DN1 = W_GU1 + (size_t)NGU * D * 2, W_WIN = W_DN1 + (size_t)D * DFF * 2, W_GLU = W_WIN + (size_t)NIN * D * 2, W_WOUT = W_GLU + 512 * 512 * 2,
                 W_GU2 = W_WOUT + (size_t)D * D * 2, W_DN2 = W_GU2 + (size_t)NGU * D * 2, W_LORA = W_DN2 + (size_t)D * DFF * 2, W_LAYER = W_LORA + 768 * 256 * 2;
constexpr size_t WS_SK = WS_W + 4 * W_LAYER;
constexpr size_t WS_SKC = WS_SK + (size_t)2 * 256 * 262144;
constexpr size_t SKC_BYTES = (size_t)48 * 96 * 64;
constexpr size_t WS_END = WS_SKC + SKC_BYTES;
constexpr int CW_BAR = 0, CW_Q = 4096, CW_CONV = 8192;
constexpr int MISC_OFF = 150528, LDS_BYTES = 150528 + 3072;

struct Args { const float* in[N_IN]; float* out; unsigned char* ws; int ph_lo, ph_hi; };

__device__ __forceinline__ const float* inp(const Args& a, int i) { asm volatile("" : "+s"(i)); return a.in[i]; }
__device__ __forceinline__ int otid() { int t = threadIdx.x; asm volatile("" : "+v"(t)); return t; }
__device__ __forceinline__ float wave_sum(float x) {
#pragma unroll
    for (int o = 32; o > 0; o >>= 1) x += __shfl_xor(x, o);
    return x;
}
template <int CTRL> __device__ __forceinline__ float dpp_f(float x) { return __builtin_bit_cast(float, __builtin_amdgcn_update_dpp(0, __builtin_bit_cast(int, x), CTRL, 0xF, 0xF, true)); }
__device__ __forceinline__ float row16_sum(float x) { x += dpp_f<0xB1>(x); x += dpp_f<0x4E>(x); x += dpp_f<0x141>(x); x += dpp_f<0x140>(x); return x; }
__device__ __forceinline__ float sigmoid_f(float x) { return __builtin_amdgcn_rcpf(1.0f + __expf(-x)); }
__device__ __forceinline__ float silu_f(float x) { return x * sigmoid_f(x); }
__device__ __forceinline__ float tanh_f(float x) { return 1.0f - 2.0f * __builtin_amdgcn_rcpf(__expf(2.0f * x) + 1.0f); }
__device__ __forceinline__ float gelu_tanh_f(float x) { return 0.5f * x * (1.0f + tanh_f(0.7978845608028654f * (x + 0.044715f * x * x * x))); }
__device__ __forceinline__ unsigned short bf16_1(float x) { return (unsigned short)(cvt_pk_bf16(x, 0.f) & 0xffffu); }

struct EpiSwiGLU {
    static constexpr bool PERM = false, AFTER_DRAIN = false;
    bf16_t* H; const float* rstd; const MK_LDS float* rs;
    __device__ __forceinline__ void emit(const f32x4 (&v)[2][2], float r, int row, int col0) const {
        float h[8];
#pragma unroll
        for (int n = 0; n < 2; ++n)
#pragma unroll
            for (int i = 0; i < 4; ++i) h[4 * n + i] = silu_f(v[0][n][i] * r) * (v[1][n][i] * r);
        u32x4 w; w.x = cvt_pk_bf16(h[0], h[1]); w.y = cvt_pk_bf16(h[2], h[3]); w.z = cvt_pk_bf16(h[4], h[5]); w.w = cvt_pk_bf16(h[6], h[7]);
        *(u32x4*)(H + (size_t)row * DFF + col0) = w;
    }
    __device__ __forceinline__ void group(const f32x4 (&v)[2][2], const pg8::Unit& u, int ai, int m, int wr, int wc, int fr, int fq) const {
        const int row = u.pm * 256 + wr * 64 + fr + ai * 128 + m * 16, col0 = u.pn * 128 + wc * 32 + 8 * fq;
        emit(v, rstd[row], row, col0);
    }
    __device__ __forceinline__ void operator()(const f32x4 (&acc)[2][2][4][2], const pg8::Unit& u, int wr, int wc, int fr, int fq) const {
        const int row0 = u.pm * 256 + wr * 64 + fr, col0 = u.pn * 128 + wc * 32 + 8 * fq;
        float rr[2][4];
#pragma unroll
        for (int ai = 0; ai < 2; ++ai)
#pragma unroll
            for (int m = 0; m < 4; ++m) rr[ai][m] = rs[u.slot * 256 + wr * 64 + fr + ai * 128 + m * 16];
#pragma unroll
        for (int ai = 0; ai < 2; ++ai)
#pragma unroll
            for (int m = 0; m < 4; ++m) { const f32x4 v[2][2] = {{acc[ai][0][m][0], acc[ai][0][m][1]}, {acc[ai][1][m][0], acc[ai][1][m][1]}}; emit(v, rr[ai][m], row0 + ai * 128 + m * 16, col0); }
    }
};
struct EpiResid {
    static constexpr bool PERM = false, AFTER_DRAIN = false;
    bf16_t* X; float s;
    static __device__ __forceinline__ f32x4 up4(unsigned x, unsigned y) { return (f32x4){__uint_as_float(x << 16), __uint_as_float(x & 0xffff0000u), __uint_as_float(y << 16), __uint_as_float(y & 0xffff0000u)}; }
    static __device__ __forceinline__ void rmw(bf16_t* p, const f32x4 a0, const f32x4 a1, const u32x4 xw, float s) {
        unsigned ax = xw.x, ay = xw.y, bx = xw.z, by = xw.w;
        { const auto t = __builtin_amdgcn_permlane16_swap(ax, bx, false, false); ax = t[0]; bx = t[1]; }
        { const auto t = __builtin_amdgcn_permlane16_swap(ay, by, false, false); ay = t[0]; by = t[1]; }
        const f32x4 v0 = up4(ax, ay) + a0 * s, v1 = up4(bx, by) + a1 * s;
        ax = cvt_pk_bf16(v0[0], v0[1]); ay = cvt_pk_bf16(v0[2], v0[3]); bx = cvt_pk_bf16(v1[0], v1[1]); by = cvt_pk_bf16(v1[2], v1[3]);
        { const auto t = __builtin_amdgcn_permlane16_swap(ax, bx, false, false); ax = t[0]; bx = t[1]; }
        { const auto t = __builtin_amdgcn_permlane16_swap(ay, by, false, false); ay = t[0]; by = t[1]; }
        *(u32x4*)p = (u32x4){ax, ay, bx, by};
    }
    __device__ __forceinline__ void group(const f32x4 (&v)[2][2], const pg8::Unit& u, int ai, int m, int wr, int wc, int fr, int fq) const {
        bf16_t* rowp = X + (size_t)(u.pm * 256 + wr * 64 + fr + ai * 128 + m * 16) * D + u.pn * 256 + wc * 32 + (fq & 1) * 16 + (fq >> 1) * 8;
        u32x4 xw[2];
#pragma unroll
        for (int bj = 0; bj < 2; ++bj) xw[bj] = *(const u32x4*)(rowp + bj * 128);
#pragma unroll
        for (int bj = 0; bj < 2; ++bj) rmw(rowp + bj * 128, v[bj][0], v[bj][1], xw[bj], s);
    }
    __device__ __forceinline__ void operator()(const f32x4 (&acc)[2][2][4][2], const pg8::Unit& u, int wr, int wc, int fr, int fq) const {
        bf16_t* base = X + (size_t)(u.pm * 256 + wr * 64 + fr) * D + u.pn * 256 + wc * 32 + (fq & 1) * 16 + (fq >> 1) * 8;
#pragma unroll
        for (int ai = 0; ai < 2; ++ai) {
            u32x4 xw[4][2];
#pragma unroll
            for (int m = 0; m < 4; ++m)
#pragma unroll
                for (int bj = 0; bj < 2; ++bj) xw[m][bj] = *(const u32x4*)(base + (size_t)(ai * 128 + m * 16) * D + bj * 128);
#pragma unroll
            for (int m = 0; m < 4; ++m)
#pragma unroll
                for (int bj = 0; bj < 2; ++bj) rmw(base + (size_t)(ai * 128 + m * 16) * D + bj * 128, acc[ai][bj][m][0], acc[ai][bj][m][1], xw[m][bj], s); }
    }
};
__device__ __forceinline__ float pbf(const bf16_t* p) { return __uint_as_float(((unsigned)*p) << 16); }
__device__ __forceinline__ f32x4 pbf4(const bf16_t* p) { const u32x2 w = *(const u32x2*)p; return (f32x4){__uint_as_float(w.x << 16), __uint_as_float(w.x & 0xffff0000u), __uint_as_float(w.y << 16), __uint_as_float(w.y & 0xffff0000u)}; }
struct EpiStoreP {
    static constexpr bool PERM = false, AFTER_DRAIN = false;
    float* C; int ldc; const float* rstd; const MK_LDS float* rs;
    __device__ __forceinline__ void emit(const f32x4 (&v)[2][2], float r, const pg8::Unit& u, size_t off) const {
        if (u.pm < NPR / 256) {
            const int fq_ = (int)((off >> 2) & 3);
            bf16_t* rowp = (bf16_t*)C + (off - 4 * fq_) + (fq_ & 1) * 16 + (fq_ >> 1) * 8;
#pragma unroll
            for (int bj = 0; bj < 2; ++bj) { const f32x4 t0 = v[bj][0] * r, t1 = v[bj][1] * r;
                unsigned ax = cvt_pk_bf16(t0[0], t0[1]), ay = cvt_pk_bf16(t0[2], t0[3]), bx = cvt_pk_bf16(t1[0], t1[1]), by = cvt_pk_bf16(t1[2], t1[3]);
                { const auto s = __builtin_amdgcn_permlane16_swap(ax, bx, false, false); ax = s[0]; bx = s[1]; }
                { const auto s = __builtin_amdgcn_permlane16_swap(ay, by, false, false); ay = s[0]; by = s[1]; }
                *(u32x4*)(rowp + bj * 128) = (u32x4){ax, ay, bx, by}; } }
        else { float* rowp = C + off;
#pragma unroll
            for (int bj = 0; bj < 2; ++bj)
#pragma unroll
                for (int n = 0; n < 2; ++n) *(f32x4*)(rowp + bj * 128 + n * 16) = v[bj][n] * r; }
    }
    __device__ __forceinline__ void group(const f32x4 (&v)[2][2], const pg8::Unit& u, int ai, int m, int wr, int wc, int fr, int fq) const {
        const int row = u.pm * 256 + wr * 64 + fr + ai * 128 + m * 16;
        emit(v, rstd[row], u, (size_t)row * ldc + u.pn * 256 + wc * 32 + 4 * fq);
    }
    __device__ __forceinline__ void operator()(const f32x4 (&acc)[2][2][4][2], const pg8::Unit& u, int wr, int wc, int fr, int fq) const {
        const int row0 = u.pm * 256 + wr * 64 + fr;
        float rr[2][4];
#pragma unroll
        for (int ai = 0; ai < 2; ++ai)
#pragma unroll
            for (int m = 0; m < 4; ++m) rr[ai][m] = rs[u.slot * 256 + wr * 64 + fr + ai * 128 + m * 16];
#pragma unroll
        for (int ai = 0; ai < 2; ++ai)
#pragma unroll
            for (int m = 0; m < 4; ++m) { const f32x4 v[2][2] = {{acc[ai][0][m][0], acc[ai][0][m][1]}, {acc[ai][1][m][0], acc[ai][1][m][1]}};
                emit(v, rr[ai][m], u, (size_t)(row0 + ai * 128 + m * 16) * ldc + u.pn * 256 + wc * 32 + 4 * fq); }
    }
};
struct EpiStoreF32 {
    static constexpr bool PERM = false, AFTER_DRAIN = false;
    float* C; int ldc;
    __device__ __forceinline__ void group(const f32x4 (&v)[2][2], const pg8::Unit& u, int ai, int m, int wr, int wc, int fr, int fq) const {
        float* rowp = C + (size_t)(u.pm * 256 + wr * 64 + fr + ai * 128 + m * 16) * ldc + u.pn * 256 + wc * 32 + 4 * fq;
#pragma unroll
        for (int bj = 0; bj < 2; ++bj)
#pragma unroll
            for (int n = 0; n < 2; ++n) *(f32x4*)(rowp + bj * 128 + n * 16) = v[bj][n];
    }
    __device__ __forceinline__ void operator()(const f32x4 (&acc)[2][2][4][2], const pg8::Unit& u, int wr, int wc, int fr, int fq) const {
#pragma unroll
        for (int ai = 0; ai < 2; ++ai)
#pragma unroll
            for (int m = 0; m < 4; ++m) { const f32x4 v[2][2] = {{acc[ai][0][m][0], acc[ai][0][m][1]}, {acc[ai][1][m][0], acc[ai][1][m][1]}}; group(v, u, ai, m, wr, wc, fr, fq); }
    }
};
struct EpiGLU {
    static constexpr bool PERM = false, AFTER_DRAIN = false;
    const bf16_t* Y; const float* bias; bf16_t* MIX;
    static __device__ __forceinline__ f32x4 up4(unsigned x, unsigned y) { return (f32x4){__uint_as_float(x << 16), __uint_as_float(x & 0xffff0000u), __uint_as_float(y << 16), __uint_as_float(y & 0xffff0000u)}; }
    __device__ __forceinline__ void group(const f32x4 (&v)[2][2], const pg8::Unit& u, int ai, int m, int wr, int wc, int fr, int fq) const {
        const int row = u.pm * 256 + wr * 64 + fr + ai * 128 + m * 16, colw = u.pn * 256 + wc * 32, cb = (fq & 1) * 16 + (fq >> 1) * 8;
        u32x4 yw[2];
#pragma unroll
        for (int bj = 0; bj < 2; ++bj) yw[bj] = *(const u32x4*)(Y + (size_t)row * 512 + colw + bj * 128 + cb);
#pragma unroll
        for (int bj = 0; bj < 2; ++bj) { const int col = colw + bj * 128 + 4 * fq;
            unsigned ax = yw[bj].x, ay = yw[bj].y, bx = yw[bj].z, by = yw[bj].w;
            { const auto t = __builtin_amdgcn_permlane16_swap(ax, bx, false, false); ax = t[0]; bx = t[1]; }
            { const auto t = __builtin_amdgcn_permlane16_swap(ay, by, false, false); ay = t[0]; by = t[1]; }
            const f32x4 y0 = up4(ax, ay), y1 = up4(bx, by), a0 = v[bj][0] + *(const f32x4*)(bias + col), a1 = v[bj][1] + *(const f32x4*)(bias + col + 16);
            ax = cvt_pk_bf16(y0[0] * sigmoid_f(a0[0]), y0[1] * sigmoid_f(a0[1])); ay = cvt_pk_bf16(y0[2] * sigmoid_f(a0[2]), y0[3] * sigmoid_f(a0[3]));
            bx = cvt_pk_bf16(y1[0] * sigmoid_f(a1[0]), y1[1] * sigmoid_f(a1[1])); by = cvt_pk_bf16(y1[2] * sigmoid_f(a1[2]), y1[3] * sigmoid_f(a1[3]));
            { const auto t = __builtin_amdgcn_permlane16_swap(ax, bx, false, false); ax = t[0]; bx = t[1]; }
            { const auto t = __builtin_amdgcn_permlane16_swap(ay, by, false, false); ay = t[0]; by = t[1]; }
            *(u32x4*)(MIX + (size_t)row * D + colw + bj * 128 + cb) = (u32x4){ax, ay, bx, by}; }
    }
    __device__ __forceinline__ void operator()(const f32x4 (&acc)[2][2][4][2], const pg8::Unit& u, int wr, int wc, int fr, int fq) const {
#pragma unroll
        for (int ai = 0; ai < 2; ++ai)
#pragma unroll
            for (int m = 0; m < 4; ++m) { const f32x4 v[2][2] = {{acc[ai][0][m][0], acc[ai][0][m][1]}, {acc[ai][1][m][0], acc[ai][1][m][1]}}; group(v, u, ai, m, wr, wc, fr, fq); }
    }
};

__device__ __forceinline__ int gu_rowmap(int h, int type) {
    const int pn = h >> 7, r = h & 127, wc = r >> 5, r2 = r & 31, fq = r2 >> 3, n = (r2 >> 2) & 1, i = r2 & 3;
    return 256 * pn + 128 * type + 32 * wc + 16 * n + 4 * fq + i;
}
struct ConvJob { const float* src; bf16_t* dst; const float* nw; int K, N, ldd, koff, mode; };
constexpr int CONV_NJ = 12;
constexpr int CONV_TILES_LAYER = 704 * 6 + 768 + 16 + 256 + 3 + 3 + 6;
__device__ __forceinline__ void conv_decode(const Args& a, int T, ConvJob& J, int& tk, int& tn) {
    const int l = T / CONV_TILES_LAYER; int r = T % CONV_TILES_LAYER;
    unsigned char* wl = a.ws + WS_W + (size_t)l * W_LAYER;
    const int cnt[CONV_NJ] = {704, 704, 704, 768, 16, 256, 704, 704, 704, 3, 3, 6};
    int j = 0;
#pragma unroll
    for (int q = 0; q < CONV_NJ - 1; ++q) { if (j == q && r >= cnt[q]) { r -= cnt[q]; j = q + 1; } }
    J.koff = 0; J.mode = 0; J.nw = nullptr;
    switch (j) {
        case 0:  J.src = inp(a, I_G1) + (size_t)l * D * DFF;  J.dst = (bf16_t*)(wl + W_GU1);  J.K = D;   J.N = DFF; J.ldd = D;   J.mode = 1; J.nw = inp(a, I_NORM1) + l * D; break;
        case 1:  J.src = inp(a, I_U1) + (size_t)l * D * DFF;  J.dst = (bf16_t*)(wl + W_GU1);  J.K = D;   J.N = DFF; J.ldd = D;   J.mode = 2; J.nw = inp(a, I_NORM1) + l * D; break;
        case 2:  J.src = inp(a, I_D1) + (size_t)l * D * DFF;  J.dst = (bf16_t*)(wl + W_DN1);  J.K = DFF; J.N = D;   J.ldd = DFF; break;
        case 3:  J.src = inp(a, I_WIN) + (size_t)l * D * NIN; J.dst = (bf16_t*)(wl + W_WIN);  J.K = D;   J.N = NIN; J.ldd = D;   J.nw = inp(a, I_NORMM) + l * D; break;
        case 4:  J.src = inp(a, I_WGLU) + (size_t)l * 512 * 512; J.dst = (bf16_t*)(wl + W_GLU); J.K = 512; J.N = 512; J.ldd = 512; break;
        case 5:  J.src = inp(a, I_WOUT) + (size_t)l * D * D;  J.dst = (bf16_t*)(wl + W_WOUT); J.K = D;   J.N = D;   J.ldd = D;   break;
        case 6:  J.src = inp(a, I_G2F) + (size_t)l * D * DFF; J.dst = (bf16_t*)(wl + W_GU2);  J.K = D;   J.N = DFF; J.ldd = D;   J.mode = 1; J.nw = inp(a, I_NORM2) + l * D; break;
        case 7:  J.src = inp(a, I_U2F) + (size_t)l * D * DFF; J.dst = (bf16_t*)(wl + W_GU2);  J.K = D;   J.N = DFF; J.ldd = D;   J.mode = 2; J.nw = inp(a, I_NORM2) + l * D; break;
        case 8:  J.src = inp(a, I_D2F) + (size_t)l * D * DFF; J.dst = (bf16_t*)(wl + W_DN2);  J.K = DFF; J.N = D;   J.ldd = DFF; break;
        case 9:  J.src = inp(a, I_W2) + (size_t)l * 64 * 768;  J.dst = (bf16_t*)(wl + W_LORA); J.K = 64;  J.N = 768; J.ldd = 256; J.koff = 0;   break;
        case 10: J.src = inp(a, I_A2) + (size_t)l * 64 * 768;  J.dst = (bf16_t*)(wl + W_LORA); J.K = 64;  J.N = 768; J.ldd = 256; J.koff = 64;  break;
        default: J.src = inp(a, I_G2) + (size_t)l * 128 * 768; J.dst = (bf16_t*)(wl + W_LORA); J.K = 128; J.N = 768; J.ldd = 256; J.koff = 128; break;
    }
    const int ntn = J.N / 256; tk = r / ntn; tn = r % ntn;
}
__device__ __forceinline__ void conv_load(const ConvJob& J, int tk, int tn, int tid, float4 (&v)[8], float (&sc)[8]) {
#pragma unroll
    for (int i = 0; i < 8; ++i) { const int e = tid + 512 * i, r = e >> 6, c4 = e & 63; sc[i] = J.nw ? J.nw[tk * 64 + r] : 1.0f; const f32x4 t = __builtin_nontemporal_load((const f32x4*)(J.src + (size_t)(tk * 64 + r) * J.N + tn * 256 + 4 * c4)); v[i].x = t[0]; v[i].y = t[1]; v[i].z = t[2]; v[i].w = t[3]; }
}
__device__ __forceinline__ void conv_tiles(const Args& a, int T0, int Tend, int step, MK_LDS float* tile  ) {
    const int tid = otid();
    int T = T0; if (T >= Tend) return;
    ConvJob J; int tk, tn; conv_decode(a, T, J, tk, tn);
    float4 v[8]; float sc[8]; conv_load(J, tk, tn, tid, v, sc);
    for (;;) {
        __syncthreads();
#pragma unroll
        for (int i = 0; i < 8; ++i) { const int e = tid + 512 * i, r = e >> 6, c4 = e & 63; MK_LDS float* t = tile + r * 289 + c4; t[0] = v[i].x * sc[i]; t[72] = v[i].y * sc[i]; t[144] = v[i].z * sc[i]; t[216] = v[i].w * sc[i]; }
        const ConvJob Jc = J; const int ctk = tk, ctn = tn;
        T += step; const bool more = T < Tend;
        if (more) { conv_decode(a, T, J, tk, tn); conv_load(J, tk, tn, tid, v, sc); }
        __syncthreads();
        { const int n = tid >> 1, kh = tid & 1, ng = ctn * 256 + n;
          const int drow = Jc.mode == 0 ? ng : gu_rowmap(ng, Jc.mode - 1);
          bf16_t* dp = Jc.dst + (size_t)drow * Jc.ldd + Jc.koff + ctk * 64 + 32 * kh;
#pragma unroll
          for (int m = 0; m < 4; ++m) { float f[8];
#pragma unroll
              for (int j = 0; j < 8; ++j) f[j] = tile[(32 * kh + 8 * m + j) * 289 + (n & 3) * 72 + (n >> 2)];
              u32x4 w; w.x = cvt_pk_bf16(f[0], f[1]); w.y = cvt_pk_bf16(f[2], f[3]); w.z = cvt_pk_bf16(f[4], f[5]); w.w = cvt_pk_bf16(f[6], f[7]);
              *(u32x4*)(dp + 8 * m) = w; } }
        if (!more) break;
    }
    __syncthreads();
}
constexpr int CONV_TICKETS = (CONV_TILES_LAYER + 3) / 4;
__device__ __forceinline__ void conv_work(const Args& a, int j, int max_tickets, MK_LDS unsigned char* lds) {
    if (j >= NL) return;
    const int tid = otid();
    unsigned* cnt = (unsigned*)(a.ws + WS_CTL) + CW_CONV + 64 * j;
    volatile MK_LDS unsigned* qw = (volatile MK_LDS unsigned*)(lds + MISC_OFF + 32);
    for (int it = 0; max_tickets < 0 || it < max_tickets; ++it) {
        __syncthreads();
        if (tid == 0) qw[0] = __hip_atomic_fetch_add(cnt, 1u, __ATOMIC_RELAXED, __HIP_MEMORY_SCOPE_AGENT);
        __syncthreads();
        const int t = (int)qw[0];
        if (t >= CONV_TICKETS) break;
        const int T0 = j * CONV_TILES_LAYER + 4 * t, Te = (j + 1) * CONV_TILES_LAYER;
        conv_tiles(a, T0, (T0 + 4 < Te ? T0 + 4 : Te), 1, (MK_LDS float*)lds);
    }
}
__device__ __forceinline__ void phase_prologue(const Args& a, MK_LDS float* tile  ) {
    const int tid = otid(), G = gridDim.x;
    { const int lane = tid & 63, wave = tid >> 6, stride = G * 8; float* rstd = (float*)(a.ws + WS_HB);
      for (int row = blockIdx.x * 8 + wave; row < NTOK; row += stride) {
          const float4* src = (const float4*)(row < NPR ? inp(a, I_XP) + (size_t)row * D : inp(a, I_XS) + (size_t)(row - NPR) * D);
          u32x2* dst = (u32x2*)((bf16_t*)(a.ws + WS_X) + (size_t)row * D);
          float4 v[8]; float s = 0.f;
#pragma unroll
          for (int j = 0; j < 8; ++j) v[j] = src[lane + 64 * j];
#pragma unroll
          for (int j = 0; j < 8; ++j) { u32x2 w; w.x = cvt_pk_bf16(v[j].x, v[j].y); w.y = cvt_pk_bf16(v[j].z, v[j].w); dst[lane + 64 * j] = w;
              const float a0 = __uint_as_float(w.x << 16), a1 = __uint_as_float(w.x & 0xffff0000u), a2 = __uint_as_float(w.y << 16), a3 = __uint_as_float(w.y & 0xffff0000u);
              s += (a0 * a0 + a1 * a1) + (a2 * a2 + a3 * a3); }
          s = wave_sum(s);
          if (lane == 0) rstd[row] = rsqrtf(s * (1.0f / D) + NORM_EPS); } }
    conv_tiles(a, blockIdx.x, CONV_TILES_LAYER, G, tile);
}
constexpr int RS_OFF = 131072;
__device__ __forceinline__ const MK_LDS float* stage_rstd(const MK_LDS int* tab, const float* rstd, MK_LDS unsigned char* lds) {
    MK_LDS float* rs = (MK_LDS float*)(lds + RS_OFF); const int tid = otid();
    __syncthreads();
#pragma unroll
    for (int i0 = 0; i0 < 8; i0 += 2) { const int i = i0 + (tid >> 8); if (tab[8 * i + 7] != 0 && tab[8 * i + 4] < 0) rs[i * 256 + (tid & 255)] = rstd[tab[8 * i] * 256 + (tid & 255)]; }
    __syncthreads();
    return rs;
}
__device__ __forceinline__ void phase_rstd(const bf16_t* X, float* rstd) {
    const int tid = otid(), lane = tid & 63, wave = tid >> 6;
    const int stride = gridDim.x * 8;
    for (int row0 = blockIdx.x * 8 + wave; row0 < NTOK; row0 += 2 * stride) {
        const int row1 = row0 + stride; const bool has1 = row1 < NTOK;
        const u32x4* xr0 = (const u32x4*)(X + (size_t)row0 * D); const u32x4* xr1 = (const u32x4*)(X + (size_t)(has1 ? row1 : row0) * D);
        u32x4 v0[4], v1[4]; float s0 = 0.f, s1 = 0.f;
#pragma unroll
        for (int j = 0; j < 4; ++j) { v0[j] = xr0[lane + 64 * j]; v1[j] = xr1[lane + 64 * j]; }
#pragma unroll
        for (int j = 0; j < 4; ++j)
#pragma unroll
            for (int e = 0; e < 4; ++e) { const float a0 = __uint_as_float(v0[j][e] << 16), a1 = __uint_as_float(v0[j][e] & 0xffff0000u), b0 = __uint_as_float(v1[j][e] << 16), b1 = __uint_as_float(v1[j][e] & 0xffff0000u);
                s0 += a0 * a0 + a1 * a1; s1 += b0 * b0 + b1 * b1; }
        s0 = wave_sum(s0); s1 = wave_sum(s1);
        if (lane == 0) { rstd[row0] = rsqrtf(s0 * (1.0f / D) + NORM_EPS); if (has1) rstd[row1] = rsqrtf(s1 * (1.0f / D) + NORM_EPS); }
    }
}
__device__ __forceinline__ void phase_rmsnorm(const bf16_t* X, const float* w, bf16_t* ob, float* of) {
    const int tid = otid(), lane = tid & 63, wave = tid >> 6;
    const int stride = gridDim.x * 8;
    for (int row0 = blockIdx.x * 8 + wave; row0 < NTOK; row0 += 2 * stride) {
        const int row1 = row0 + stride; const bool has1 = row1 < NTOK;
        const u32x4* xr0 = (const u32x4*)(X + (size_t)row0 * D); const u32x4* xr1 = (const u32x4*)(X + (size_t)(has1 ? row1 : row0) * D);
        u32x4 v0[4], v1[4]; float s0 = 0.f, s1 = 0.f;
#pragma unroll
        for (int j = 0; j < 4; ++j) { v0[j] = xr0[lane + 64 * j]; v1[j] = xr1[lane + 64 * j]; }
#pragma unroll
        for (int j = 0; j < 4; ++j)
#pragma unroll
            for (int e = 0; e < 4; ++e) { const float a0 = __uint_as_float(v0[j][e] << 16), a1 = __uint_as_float(v0[j][e] & 0xffff0000u), b0 = __uint_as_float(v1[j][e] << 16), b1 = __uint_as_float(v1[j][e] & 0xffff0000u);
                s0 += a0 * a0 + a1 * a1; s1 += b0 * b0 + b1 * b1; }
        s0 = wave_sum(s0); s1 = wave_sum(s1);
        const float r0 = rsqrtf(s0 * (1.0f / D) + NORM_EPS), r1 = rsqrtf(s1 * (1.0f / D) + NORM_EPS);
#pragma unroll
        for (int j = 0; j < 4; ++j) { const float4 g0 = ((const float4*)w)[2 * (lane + 64 * j)], g1 = ((const float4*)w)[2 * (lane + 64 * j) + 1];
            const float g[8] = {g0.x, g0.y, g0.z, g0.w, g1.x, g1.y, g1.z, g1.w};
#pragma unroll
            for (int rw = 0; rw < 2; ++rw) { if (rw == 1 && !has1) break;
                const u32x4 v = rw ? v1[j] : v0[j]; const float r = rw ? r1 : r0; const int row = rw ? row1 : row0;
                float y[8];
#pragma unroll
                for (int e = 0; e < 4; ++e) { y[2 * e] = __uint_as_float(v[e] << 16) * r * g[2 * e]; y[2 * e + 1] = __uint_as_float(v[e] & 0xffff0000u) * r * g[2 * e + 1]; }
                if (ob) { u32x4 p; p.x = cvt_pk_bf16(y[0], y[1]); p.y = cvt_pk_bf16(y[2], y[3]); p.z = cvt_pk_bf16(y[4], y[5]); p.w = cvt_pk_bf16(y[6], y[7]); *(u32x4*)(ob + (size_t)row * D + 8 * (lane + 64 * j)) = p; }
                else { float4 o0, o1; o0.x = y[0]; o0.y = y[1]; o0.z = y[2]; o0.w = y[3]; o1.x = y[4]; o1.y = y[5]; o1.z = y[6]; o1.w = y[7];
                       ((float4*)(of + (size_t)row * D))[2 * (lane + 64 * j)] = o0; ((float4*)(of + (size_t)row * D))[2 * (lane + 64 * j) + 1] = o1; } } }
    }
}

__device__ __forceinline__ const float* rwkv_prev(const float* P, const float* shift0, int row) {
    if (row < NPR) return (row & (TP - 1)) ? P + (size_t)(row - 1) * NIN + O_RW : nullptr;
    const int rs = row - NPR;
    return (rs & 7) ? P + (size_t)(row - 1) * NIN + O_RW : shift0 + (size_t)(rs >> 3) * RSW;
}
__device__ __forceinline__ void rwkv_prep(const Args& a, int l, MK_LDS unsigned char* lds, int t0, int t1) {
    const int tid = otid(), lane = tid & 63, wave = tid >> 6, ln = lane & 15, q = lane >> 4, G = gridDim.x;
    const float* P = (const float*)(a.ws + WS_P); float* RWB = (float*)(a.ws + WS_RW); float* BON = (float*)(a.ws + WS_BONUS);
    const float* mu = inp(a, I_MU) + l * RSW; const float* w0 = inp(a, I_W0) + l * 768; const float* a0 = inp(a, I_A0) + l * 768;
    const float* kkp = inp(a, I_KK) + l * 768; const float* kap = inp(a, I_KA) + l * 768; const float* rkp = inp(a, I_RK) + l * 768;
    const float* shift0 = inp(a, I_SHIFT) + (size_t)l * BS * RSW;
    const bf16_t* lora = (const bf16_t*)(a.ws + WS_W + (size_t)l * W_LAYER + W_LORA);
    int cur_tb = -1;
    for (int task = t0; task < t1; ++task) {
        const int tb = task / 12, head = task % 12;
        if (tb != cur_tb) {
            __syncthreads();
            const int r = tid >> 2, cg = tid & 3, row = tb * 128 + r;
            const float* zp = P + (size_t)row * NIN + O_RW + 2304 + cg * 64;
            const float* pv = rwkv_prev(P, shift0, row); const float* pvp = pv ? pv + 2304 + cg * 64 : nullptr;
            const float* mup = mu + 2304 + cg * 64;
#pragma unroll 4
            for (int j = 0; j < 16; ++j) {
                const float4 z = *(const float4*)(zp + 4 * j), m = *(const float4*)(mup + 4 * j);
                float4 p = {0.f, 0.f, 0.f, 0.f}; if (pvp) p = *(const float4*)(pvp + 4 * j);
                float v0 = z.x + (p.x - z.x) * m.x, v1 = z.y + (p.y - z.y) * m.y, v2 = z.z + (p.z - z.z) * m.z, v3 = z.w + (p.w - z.w) * m.w;
                if (cg == 0) { v0 = tanh_f(v0); v1 = tanh_f(v1); v2 = tanh_f(v2); v3 = tanh_f(v3); }
                else if (cg >= 2) { v0 = sigmoid_f(v0); v1 = sigmoid_f(v1); v2 = sigmoid_f(v2); v3 = sigmoid_f(v3); }
                u32x2 w; w.x = cvt_pk_bf16(v0, v1); w.y = cvt_pk_bf16(v2, v3);
                *(MK_LDS u32x2*)(lds + r * 528 + (cg * 64 + 4 * j) * 2) = w;
            }
            __syncthreads(); cur_tb = tb;
        }
        bf16x8 af[8];
#pragma unroll
        for (int s = 0; s < 8; ++s) af[s] = *(const MK_LDS bf16x8*)(lds + (16 * wave + ln) * 528 + (32 * s + 8 * q) * 2);
        f32x4 aw[4], aa[4], ag[4];
#pragma unroll
        for (int nt = 0; nt < 4; ++nt) {
            aw[nt] = (f32x4){0.f, 0.f, 0.f, 0.f}; aa[nt] = aw[nt]; ag[nt] = aw[nt];
            const bf16_t* bp = lora + (size_t)(head * 64 + nt * 16 + ln) * 256 + 8 * q;
#pragma unroll
            for (int s = 0; s < 8; ++s) { const bf16x8 b = *(const bf16x8*)(bp + 32 * s);
                if (s < 2) aw[nt] = __builtin_amdgcn_mfma_f32_16x16x32_bf16(af[s], b, aw[nt], 0, 0, 0);
                else if (s < 4) aa[nt] = __builtin_amdgcn_mfma_f32_16x16x32_bf16(af[s], b, aa[nt], 0, 0, 0);
                else ag[nt] = __builtin_amdgcn_mfma_f32_16x16x32_bf16(af[s], b, ag[nt], 0, 0, 0); }
        }
        const int rbase = tb * 128 + 16 * wave + 4 * q;
        float ss[4] = {0.f, 0.f, 0.f, 0.f}, bn[4] = {0.f, 0.f, 0.f, 0.f}, kkraw[4][4], av[4][4];
#pragma unroll
        for (int nt = 0; nt < 4; ++nt) {
            const int c = 16 * nt + ln, C = head * 64 + c;
            const float mr = mu[C], mk_ = mu[768 + C], mv = mu[1536 + C], w0c = w0[C], a0c = a0[C], kkc = kkp[C], kac = kap[C], rkc = rkp[C];
#pragma unroll
            for (int i = 0; i < 4; ++i) {
                const int row = rbase + i;
                const float* zp = P + (size_t)row * NIN + O_RW + C; const float* pv = rwkv_prev(P, shift0, row);
                const float zr = zp[0], zk = zp[768], zv = zp[1536];
                float pr = 0.f, pk = 0.f, pvv = 0.f; if (pv) { pr = pv[C]; pk = pv[768 + C]; pvv = pv[1536 + C]; }
                const float rr = zr + (pr - zr) * mr, kz = zk + (pk - zk) * mk_, vz = zv + (pvv - zv) * mv;
                const float x = -(w0c + aw[nt][i]);
                const float sp = fmaxf(x, 0.f) + __logf(1.0f + __expf(-fabsf(x)));
                const float wl = -sp - 0.5f, dec = __expf(-__expf(wl));
                const float aval = sigmoid_f(a0c + aa[nt][i]);
                const float kr = kz * kkc, kmod = kz * (1.0f + (aval - 1.0f) * kac);
                kkraw[nt][i] = kr; av[nt][i] = aval; ss[i] += kr * kr; bn[i] += rr * kmod * rkc;
                float* o = RWB + ((size_t)row * 12 + head) * 448 + c;
                o[0] = rr; o[64] = kmod; o[128] = vz; o[192] = dec; o[384] = ag[nt][i];
            }
        }
#pragma unroll
        for (int i = 0; i < 4; ++i) { ss[i] = row16_sum(ss[i]); bn[i] = row16_sum(bn[i]); }
#pragma unroll
        for (int nt = 0; nt < 4; ++nt)
#pragma unroll
            for (int i = 0; i < 4; ++i) { const float kn = kkraw[nt][i] * rsqrtf(fmaxf(ss[i], 1e-24f));
                float* o = RWB + ((size_t)(rbase + i) * 12 + head) * 448 + 16 * nt + ln; o[256] = kn; o[320] = kn * av[nt][i]; }
        if (ln == 0) {
#pragma unroll
            for (int i = 0; i < 4; ++i) BON[(size_t)(rbase + i) * 12 + head] = bn[i]; }
    }
}
__device__ __forceinline__ void hgrn_prep(const Args& a, int l) {
    float* P = (float*)(a.ws + WS_P); const float* lbr = inp(a, I_LBRAW);
    const size_t n4 = (size_t)1024 * 384;
    const int tid = otid();
    for (size_t e = (size_t)blockIdx.x * 512 + tid; e < n4; e += (size_t)gridDim.x * 512) {
        const int row = NPR + (int)(e / 384), c4 = (int)(e % 384);
        float4* p = (float4*)(P + (size_t)row * NIN + O_HG) + c4; float4 v = *p;
        if (c4 < 192) { v.x = silu_f(v.x); v.y = silu_f(v.y); v.z = silu_f(v.z); v.w = silu_f(v.w); }
        else {
            const int c = 4 * (c4 - 192); float lb[4];
#pragma unroll
            for (int k = 0; k < 4; ++k) { const float r0 = lbr[c + k], r1 = lbr[768 + c + k], r2 = lbr[1536 + c + k], r3 = lbr[2304 + c + k];
                const float mx = fmaxf(fmaxf(r0, r1), fmaxf(r2, r3)), e0 = expf(r0 - mx), e1 = expf(r1 - mx), e2 = expf(r2 - mx), e3 = expf(r3 - mx), inv = 1.0f / (e0 + e1 + e2 + e3);
                lb[k] = (l == 0 ? 0.f : l == 1 ? e1 : l == 2 ? e1 + e2 : e1 + e2 + e3) * inv; }
            v.x = lb[0] + (1.0f - lb[0]) * sigmoid_f(v.x); v.y = lb[1] + (1.0f - lb[1]) * sigmoid_f(v.y); v.z = lb[2] + (1.0f - lb[2]) * sigmoid_f(v.z); v.w = lb[3] + (1.0f - lb[3]) * sigmoid_f(v.w);
        }
        *p = v;
    }
}

typedef short bf16x4 __attribute__((ext_vector_type(4)));
struct S5Par { float abr, abi; bf16x4 bre[4], bim[4]; };
constexpr int S5_UT = 0, S5_XT = 4096, S5_BU = 4096 + 4352, S5_WAVE_LDS = 4096 + 4352 + 9216;
__device__ __forceinline__ void s5_setup(const Args& a, int l, int g, int lane, S5Par& S, MK_LDS unsigned char* wl) {
    const int p = lane, ln = lane & 15, q = lane >> 4, gp = (l * 32 + g) * 64 + p;
    const float ar = inp(a, I_AARE)[gp], ai = inp(a, I_AAIM)[gp], dt = expf(inp(a, I_LOGDT)[l * 32 + g]);
    const float em = expm1f(ar * dt), ang = ai * dt, cs = cosf(ang), sn = sinf(ang), sh = sinf(0.5f * ang), mag = em + 1.0f;
    S.abr = mag * cs; S.abi = mag * sn;
    const float m1r = em * cs - 2.0f * sh * sh, m1i = mag * sn, den = 1.0f / (ar * ar + ai * ai);
    const float cr = (m1r * ar + m1i * ai) * den, ci = (m1i * ar - m1r * ai) * den;
    const float4* br = (const float4*)(inp(a, I_BRE) + (size_t)gp * 16); const float4* bi = (const float4*)(inp(a, I_BIM) + (size_t)gp * 16);
    MK_LDS unsigned char* img = wl + S5_BU + p * 64;
#pragma unroll
    for (int j = 0; j < 4; ++j) { const float4 r = br[j], i = bi[j];
        *(MK_LDS u32x2*)(img + 8 * j) = (u32x2){cvt_pk_bf16(cr * r.x - ci * i.x, cr * r.y - ci * i.y), cvt_pk_bf16(cr * r.z - ci * i.z, cr * r.w - ci * i.w)};
        *(MK_LDS u32x2*)(img + 32 + 8 * j) = (u32x2){cvt_pk_bf16(cr * i.x + ci * r.x, cr * i.y + ci * r.y), cvt_pk_bf16(cr * i.z + ci * r.z, cr * i.w + ci * r.w)}; }
    __builtin_amdgcn_wave_barrier(); asm volatile("s_waitcnt lgkmcnt(0)" ::: "memory");
#pragma unroll
    for (int pt = 0; pt < 4; ++pt) { const MK_LDS unsigned char* rowp = wl + S5_BU + (16 * pt + ln) * 64;
        S.bre[pt] = __builtin_bit_cast(bf16x4, *(const MK_LDS u32x2*)(rowp + 8 * q)); S.bim[pt] = __builtin_bit_cast(bf16x4, *(const MK_LDS u32x2*)(rowp + 32 + 8 * q)); }
    __builtin_amdgcn_wave_barrier(); asm volatile("s_waitcnt lgkmcnt(0)" ::: "memory");
}
__device__ __forceinline__ void s5_load_u(const float* P, int row0, int nrows, int g, int lane, MK_LDS float* ut) {
    const f32x4 z = {0.f, 0.f, 0.f, 0.f};
    const int row = row0 + (lane < nrows ? lane : 0);
    if (row0 < NPR) { const bf16_t* src = (const bf16_t*)P + (size_t)row * NIN + g * 16;
#pragma unroll
        for (int j = 0; j < 4; ++j) *(MK_LDS f32x4*)(ut + lane * 16 + 4 * j) = lane < nrows ? pbf4(src + 4 * j) : z; }
    else { const f32x4* src = (const f32x4*)(P + (size_t)row * NIN + g * 16);
#pragma unroll
        for (int j = 0; j < 4; ++j) *(MK_LDS f32x4*)(ut + lane * 16 + 4 * j) = lane < nrows ? src[j] : z; }
    __builtin_amdgcn_wave_barrier(); asm volatile("s_waitcnt lgkmcnt(0)" ::: "memory");
}
template <bool XOUT> __device__ __forceinline__ void s5_block(const S5Par& S, MK_LDS unsigned char* wl, int sb, int ns, int lane, float& xr, float& xi) {
    const int ln = lane & 15, q = lane >> 4;
    const MK_LDS float* ut = (const MK_LDS float*)(wl + S5_UT);
    bf16x4 af; { const f32x4 u0 = *(const MK_LDS f32x4*)(ut + (16 * sb + ln) * 16 + 4 * q); u32x2 w; w.x = cvt_pk_bf16(u0[0], u0[1]); w.y = cvt_pk_bf16(u0[2], u0[3]); af = __builtin_bit_cast(bf16x4, w); }
#pragma unroll
    for (int pt = 0; pt < 4; ++pt) { const f32x4 z = {0.f, 0.f, 0.f, 0.f};
        f32x4 br = __builtin_amdgcn_mfma_f32_16x16x16bf16_1k(af, S.bre[pt], z, 0, 0, 0), bi = __builtin_amdgcn_mfma_f32_16x16x16bf16_1k(af, S.bim[pt], z, 0, 0, 0);
        *(MK_LDS f32x4*)(wl + S5_BU + (16 * pt + ln) * 144 + 16 * q) = br; *(MK_LDS f32x4*)(wl + S5_BU + (16 * pt + ln) * 144 + 64 + 16 * q) = bi; }
    __builtin_amdgcn_wave_barrier(); asm volatile("s_waitcnt lgkmcnt(0)" ::: "memory");
    f32x4 rr[4], ii[4];
#pragma unroll
    for (int j = 0; j < 4; ++j) { rr[j] = *(const MK_LDS f32x4*)(wl + S5_BU + lane * 144 + 16 * j); ii[j] = *(const MK_LDS f32x4*)(wl + S5_BU + lane * 144 + 64 + 16 * j); }
#pragma unroll
    for (int t = 0; t < 16; ++t) { if (t < ns) { const float nxr = S.abr * xr - S.abi * xi + rr[t >> 2][t & 3], nxi = S.abr * xi + S.abi * xr + ii[t >> 2][t & 3]; xr = nxr; xi = nxi; }
        if (XOUT) { *(MK_LDS unsigned short*)(wl + S5_XT + t * 272 + lane * 2) = bf16_1(xr); *(MK_LDS unsigned short*)(wl + S5_XT + t * 272 + 128 + lane * 2) = bf16_1(xi); } }
    __builtin_amdgcn_wave_barrier(); asm volatile("s_waitcnt lgkmcnt(0)" ::: "memory");
}
__device__ __forceinline__ void s5a_wave(const Args& a, int l, int wt, MK_LDS unsigned char* wl) {
    const int lane = otid() & 63, n = wt >> 10, g = (wt >> 5) & 31, c = wt & 31;
    const float* P = (const float*)(a.ws + WS_P); float* E = (float*)(a.ws + WS_S5E);
    S5Par S; s5_setup(a, l, g, lane, S, wl);
    s5_load_u(P, n * TP + c * 64, 64, g, lane, (MK_LDS float*)(wl + S5_UT));
    float xr = 0.f, xi = 0.f;
#pragma unroll 1
    for (int sb = 0; sb < 4; ++sb) s5_block<false>(S, wl, sb, 16, lane, xr, xi);
    float* e = E + (size_t)((n * 32 + g) * 32 + c) * 128; e[lane] = xr; e[64 + lane] = xi;
    __builtin_amdgcn_wave_barrier();
}
__device__ __forceinline__ void s5c_wave(const Args& a, int l, int wt, MK_LDS unsigned char* wl) {
    const int lane = otid() & 63, ln = lane & 15, q = lane >> 4;
    const float* P = (const float*)(a.ws + WS_P); const float* E = (const float*)(a.ws + WS_S5E);
    bf16_t* YB = (bf16_t*)(a.ws + WS_YS5B);
    const MK_LDS float* ut = (const MK_LDS float*)(wl + S5_UT); const MK_LDS unsigned char* xt = wl + S5_XT;
    int n, g, c, T, row0; bool last; float xr, xi; float* ore; float* oim;
    const bool prompt = wt < 4096;
    if (prompt) { n = wt >> 10; g = (wt >> 5) & 31; c = wt & 31; T = 64; row0 = n * TP + c * 64; last = (c == 31);
        ore = a.out + O_S5RE_P + (size_t)((l * 4 + n) * 32 + g) * 64; oim = a.out + O_S5IM_P + (size_t)((l * 4 + n) * 32 + g) * 64; }
    else { const int i = wt - 4096; n = i >> 5; g = i & 31; c = 0; T = 8; row0 = NPR + n * 8; last = true;
        ore = a.out + O_S5RE_S + (size_t)((l * 128 + n) * 32 + g) * 64; oim = a.out + O_S5IM_S + (size_t)((l * 128 + n) * 32 + g) * 64; }
    S5Par S; s5_setup(a, l, g, lane, S, wl);
    if (prompt) {
        float pr = S.abr, pi = S.abi;
#pragma unroll
        for (int k = 0; k < 6; ++k) { const float t = pr * pr - pi * pi; pi = 2.0f * pr * pi; pr = t; }
        xr = 0.f; xi = 0.f;
        const float* e = E + (size_t)((n * 32 + g) * 32) * 128;
        for (int j0 = 0; j0 < c; j0 += 8) {
            float er[8], ei[8];
#pragma unroll
            for (int j = 0; j < 8; ++j) { const bool ok = j0 + j < c; er[j] = ok ? e[(j0 + j) * 128 + lane] : 0.f; ei[j] = ok ? e[(j0 + j) * 128 + 64 + lane] : 0.f; }
#pragma unroll
            for (int j = 0; j < 8; ++j) if (j0 + j < c) { const float t = xr * pr - xi * pi + er[j]; xi = xr * pi + xi * pr + ei[j]; xr = t; } }
    } else { const size_t so = (size_t)((l * 128 + n) * 32 + g) * 64 + lane; xr = inp(a, I_S5RE)[so]; xi = inp(a, I_S5IM)[so]; }
    s5_load_u(P, row0, T, g, lane, (MK_LDS float*)(wl + S5_UT));
    bf16x8 cb[4];
#pragma unroll
    for (int s = 0; s < 4; ++s) { const float* cp = (s < 2 ? inp(a, I_CRE) : inp(a, I_CIM)) + (size_t)((l * 32 + g) * 16 + ln) * 64 + 32 * (s & 1) + 8 * q;
        const float4 c0 = *(const float4*)cp, c1 = *(const float4*)(cp + 4); const float sg = s < 2 ? 1.0f : -1.0f;
        u32x4 w; w.x = cvt_pk_bf16(sg * c0.x, sg * c0.y); w.y = cvt_pk_bf16(sg * c0.z, sg * c0.w); w.z = cvt_pk_bf16(sg * c1.x, sg * c1.y); w.w = cvt_pk_bf16(sg * c1.z, sg * c1.w);
        cb[s] = __builtin_bit_cast(bf16x8, w); }
    const float dpar = inp(a, I_S5D)[l * 512 + g * 16 + ln];
#pragma unroll 1
    for (int sb = 0; sb * 16 < T; ++sb) {
        const int ns = (T - sb * 16) < 16 ? (T - sb * 16) : 16;
        s5_block<true>(S, wl, sb, ns, lane, xr, xi);
        f32x4 acc = {0.f, 0.f, 0.f, 0.f};
#pragma unroll
        for (int s = 0; s < 4; ++s) { const bf16x8 af = *(const MK_LDS bf16x8*)(xt + ln * 272 + (32 * s + 8 * q) * 2); acc = __builtin_amdgcn_mfma_f32_16x16x32_bf16(af, cb[s], acc, 0, 0, 0); }
#pragma unroll
        for (int i = 0; i < 4; ++i) { const int tl = 4 * q + i;
            if (tl < ns) { const int tt = sb * 16 + tl; const float yv = gelu_tanh_f(acc[i] + dpar * ut[tt * 16 + ln]);
                const size_t o = (size_t)(row0 + tt) * 512 + g * 16 + ln; YB[o] = bf16_1(yv); } }
        __builtin_amdgcn_wave_barrier(); asm volatile("s_waitcnt lgkmcnt(0)" ::: "memory");
    }
    if (last) { ore[lane] = xr; oim[lane] = xi; }
}

constexpr int SC_CH = 32;
__device__ __forceinline__ void rwkv_scan_task(const float* RWB, float* YRW, int row0, int T, int head, int half, const float* s0, float* sout, MK_LDS float* buf) {
    const int tid = otid(), lane = tid & 63, wave = tid >> 6, kq = lane & 15, rq = lane >> 4, vrow = half * 32 + wave * 4 + rq;
    float S0 = 0.f, S1 = 0.f, S2 = 0.f, S3 = 0.f;
    if (s0) { const float4 t = *(const float4*)(s0 + vrow * 64 + 4 * kq); S0 = t.x; S1 = t.y; S2 = t.z; S3 = t.w; }
    const int nch = (T + SC_CH - 1) / SC_CH;
    f32x4 st[6];
    { const int ns = T < SC_CH ? T : SC_CH;
#pragma unroll
      for (int i = 0; i < 6; ++i) { const int e = tid + 512 * i, step = e / 96, o4 = e - step * 96;
          if (step < ns) ((MK_LDS f32x4*)buf)[e] = *(const f32x4*)(RWB + ((size_t)(row0 + step) * 12 + head) * 448 + 4 * o4); } }
    __syncthreads();
    for (int c = 0; c < nch; ++c) {
        const int t0 = c * SC_CH, ns = (T - t0) < SC_CH ? (T - t0) : SC_CH;
        const bool more = c + 1 < nch; const int ns2 = more ? ((T - t0 - SC_CH) < SC_CH ? (T - t0 - SC_CH) : SC_CH) : 0;
        if (more) {
#pragma unroll
            for (int i = 0; i < 6; ++i) { const int e = tid + 512 * i, step = e / 96, o4 = e - step * 96;
                if (step < ns2) st[i] = *(const f32x4*)(RWB + ((size_t)(row0 + t0 + SC_CH + step) * 12 + head) * 448 + 4 * o4); } }
        const MK_LDS float* B = buf + (c & 1) * (SC_CH * 384);
        f32x4 r4 = *(const MK_LDS f32x4*)(B + 4 * kq), k4 = *(const MK_LDS f32x4*)(B + 64 + 4 * kq), d4 = *(const MK_LDS f32x4*)(B + 192 + 4 * kq),
               kk4 = *(const MK_LDS f32x4*)(B + 256 + 4 * kq), b4 = *(const MK_LDS f32x4*)(B + 320 + 4 * kq); float vv = B[128 + vrow];
        for (int t = 0; t < ns; ++t) {
            const int tn = (t + 1 < ns) ? t + 1 : t; const MK_LDS float* Bn = B + tn * 384;
            const f32x4 nr4 = *(const MK_LDS f32x4*)(Bn + 4 * kq), nk4 = *(const MK_LDS f32x4*)(Bn + 64 + 4 * kq), nd4 = *(const MK_LDS f32x4*)(Bn + 192 + 4 * kq),
                         nkk4 = *(const MK_LDS f32x4*)(Bn + 256 + 4 * kq), nb4 = *(const MK_LDS f32x4*)(Bn + 320 + 4 * kq); const float nvv = Bn[128 + vrow];
            float dot = (S0 * kk4.x + S1 * kk4.y) + (S2 * kk4.z + S3 * kk4.w); dot = row16_sum(dot);
            const float sa = -dot;
            S0 = S0 * d4.x + (sa * b4.x + vv * k4.x); S1 = S1 * d4.y + (sa * b4.y + vv * k4.y); S2 = S2 * d4.z + (sa * b4.z + vv * k4.z); S3 = S3 * d4.w + (sa * b4.w + vv * k4.w);
            float y = (S0 * r4.x + S1 * r4.y) + (S2 * r4.z + S3 * r4.w); y = row16_sum(y);
            if (kq == 0) YRW[(size_t)(row0 + t0 + t) * 768 + head * 64 + vrow] = y;
            r4 = nr4; k4 = nk4; d4 = nd4; kk4 = nkk4; b4 = nb4; vv = nvv;
        }
        if (more) {
            MK_LDS f32x4* Bw = (MK_LDS f32x4*)(buf + ((c + 1) & 1) * (SC_CH * 384));
#pragma unroll
            for (int i = 0; i < 6; ++i) { const int e = tid + 512 * i, step = e / 96; if (step < ns2) Bw[e] = st[i]; } }
        __syncthreads();
    }
    float4 o; o.x = S0; o.y = S1; o.z = S2; o.w = S3; *(float4*)(sout + vrow * 64 + 4 * kq) = o;
}
constexpr int HG_STEP = 288;
__device__ __forceinline__ void hgrn_stage_load(const float* P, int row_first, int nsteps, int head, int cb, int tid, f32x4 (&st)[5]) {
#pragma unroll
    for (int i = 0; i < 5; ++i) { const int e = tid + 512 * i, step = e / 72, o4 = e - step * 72;
        if (step < nsteps) { const float* rp = P + (size_t)(row_first + step) * NIN + O_HG + head * 128;
            const float* src = o4 < 32 ? rp + 4 * o4 : (o4 < 64 ? rp + 768 + 4 * (o4 - 32) : rp + 1536 + cb * 32 + 4 * (o4 - 64));
            st[i] = *(const f32x4*)src; } }
}
__device__ __forceinline__ void hgrn_scan_task(const float* P, float* OHG, int row0, int T, int head, int cb, const float* s0, float* sout, MK_LDS float* buf) {
    const int tid = otid(), lane = tid & 63, wave = tid >> 6, kq = lane & 15, rq = lane >> 4, cl = wave * 4 + rq, col = cb * 32 + cl;
    float S[8];
#pragma unroll
    for (int j = 0; j < 8; ++j) S[j] = s0 ? s0[(size_t)(8 * kq + j) * 128 + col] : 0.f;
    const int nch = (T + SC_CH - 1) / SC_CH;
    f32x4 st[5];
    { const int ns = T < SC_CH ? T : SC_CH; hgrn_stage_load(P, row0, ns, head, cb, tid, st);
#pragma unroll
      for (int i = 0; i < 5; ++i) { const int e = tid + 512 * i, step = e / 72; if (step < ns) ((MK_LDS f32x4*)buf)[e] = st[i]; } }
    __syncthreads();
    for (int c = 0; c < nch; ++c) {
        const int t0 = c * SC_CH, ns = (T - t0) < SC_CH ? (T - t0) : SC_CH;
        const bool more = c + 1 < nch; const int ns2 = more ? ((T - t0 - SC_CH) < SC_CH ? (T - t0 - SC_CH) : SC_CH) : 0;
        if (more) hgrn_stage_load(P, row0 + t0 + SC_CH, ns2, head, cb, tid, st);
        const MK_LDS float* B = buf + (c & 1) * (SC_CH * HG_STEP);
        f32x4 qa = *(const MK_LDS f32x4*)(B + 8 * kq), qb = *(const MK_LDS f32x4*)(B + 8 * kq + 4), fa = *(const MK_LDS f32x4*)(B + 128 + 8 * kq), fb = *(const MK_LDS f32x4*)(B + 128 + 8 * kq + 4);
        float vv = B[256 + cl];
        for (int t = 0; t < ns; ++t) {
            const int tn = (t + 1 < ns) ? t + 1 : t; const MK_LDS float* Bn = B + tn * HG_STEP;
            const f32x4 nqa = *(const MK_LDS f32x4*)(Bn + 8 * kq), nqb = *(const MK_LDS f32x4*)(Bn + 8 * kq + 4), nfa = *(const MK_LDS f32x4*)(Bn + 128 + 8 * kq), nfb = *(const MK_LDS f32x4*)(Bn + 128 + 8 * kq + 4);
            const float nvv = Bn[256 + cl];
            S[0] = fa.x * (S[0] - vv) + vv; S[1] = fa.y * (S[1] - vv) + vv; S[2] = fa.z * (S[2] - vv) + vv; S[3] = fa.w * (S[3] - vv) + vv;
            S[4] = fb.x * (S[4] - vv) + vv; S[5] = fb.y * (S[5] - vv) + vv; S[6] = fb.z * (S[6] - vv) + vv; S[7] = fb.w * (S[7] - vv) + vv;
            float o = ((qa.x * S[0] + qa.y * S[1]) + (qa.z * S[2] + qa.w * S[3])) + ((qb.x * S[4] + qb.y * S[5]) + (qb.z * S[6] + qb.w * S[7]));
            o = row16_sum(o);
            if (kq == 0) OHG[(size_t)(row0 + t0 + t) * 768 + head * 128 + col] = o;
            qa = nqa; qb = nqb; fa = nfa; fb = nfb; vv = nvv;
        }
        if (more) {
            MK_LDS f32x4* Bw = (MK_LDS f32x4*)(buf + ((c + 1) & 1) * (SC_CH * HG_STEP));
#pragma unroll
            for (int i = 0; i < 5; ++i) { const int e = tid + 512 * i, step = e / 72; if (step < ns2) Bw[e] = st[i]; } }
        __syncthreads();
    }
#pragma unroll
    for (int j = 0; j < 8; ++j) sout[(size_t)(8 * kq + j) * 128 + col] = S[j];
}

}

namespace mk {
constexpr int RC_KT = 0, RC_ZT = 8192, RC_RH = 16384, RC_N = 24576, RC_Y0 = 40960, RC_VV = 57344, RC_GG = 73728, RC_PC = 90112, RC_BO = 90368, RC_ST = 90624, RC_BYTES = 98816;
constexpr int SL = 9216;
constexpr int S_KT = 0, S_RT = 1, S_BT = 2, S_KQ = 3, S_KTT = 4, S_VT = 5, S_KBT = 6, S_BBT = 7, S_AKKT = 8, S_ARK = 9, S_ARB = 10, S_TM = 11, S_TT = 12, S_U0T = 13;
constexpr int S_W = S_BT, S_G = S_KQ;
constexpr int LA_OFF = 14 * SL;
constexpr int XC_OFF = LA_OFF + 64 * 65 * 4;
constexpr int RA_LDS_END = XC_OFF + (4 + 8) * 64 * 4;
constexpr int IN_OFF = 8 * SL;

__device__ __forceinline__ bf16x8 ldfrag(const MK_LDS unsigned char* slot, int tile, int ks, int ln, int q) { return *(const MK_LDS bf16x8*)(slot + (16 * tile + ln) * 144 + (32 * ks + 8 * q) * 2); }
__device__ __forceinline__ f32x4 mfma16(bf16x8 a, bf16x8 b, f32x4 c) { return __builtin_amdgcn_mfma_f32_16x16x32_bf16(a, b, c, 0, 0, 0); }
__device__ __forceinline__ u32x2 pack4(float a, float b, float c, float d) { u32x2 w; w.x = cvt_pk_bf16(a, b); w.y = cvt_pk_bf16(c, d); return w; }
__device__ __forceinline__ float bf2f(unsigned short h) { return __uint_as_float(((unsigned)h) << 16); }
#define WG_SYNC() do { asm volatile("s_waitcnt lgkmcnt(0)" ::: "memory"); __builtin_amdgcn_s_barrier(); asm volatile("" ::: "memory"); } while (0)

__device__ __forceinline__ void rwkv_chunk_a(const Args& a, int l, int n, int head, int c, MK_LDS unsigned char* lds) {
    const int tid = otid(), lane = tid & 63, wave = tid >> 6, ln = lane & 15, q = lane >> 4;
    const bf16_t* P = (const bf16_t*)(a.ws + WS_P);
    const float* mu = inp(a, I_MU) + l * RSW; const float* w0 = inp(a, I_W0) + l * 768; const float* a0 = inp(a, I_A0) + l * 768;
    const float* kkp = inp(a, I_KK) + l * 768; const float* kap = inp(a, I_KA) + l * 768; const float* rkp = inp(a, I_RK) + l * 768;
    const bf16_t* lora = (const bf16_t*)(a.ws + WS_W + (size_t)l * W_LAYER + W_LORA);
    unsigned char* rec = a.ws + WS_RWC + (size_t)((n * 12 + head) * 32 + c) * RC_BYTES;
    const int R0 = n * TP + c * 64;
    MK_LDS float* LA = (MK_LDS float*)(lds + LA_OFF); MK_LDS float* XC = (MK_LDS float*)(lds + XC_OFF);
    { const int r = tid >> 3, sub = tid & 7, row = R0 + r;
      const bf16_t* zp = P + (size_t)row * NIN + O_RW + 2304 + sub * 32; const float* mup = mu + 2304 + sub * 32;
      const bool hasp = (row & (TP - 1)) != 0; const bf16_t* pp = zp - NIN;
      u32x4 zw[4], pw[4];
#pragma unroll
      for (int j = 0; j < 4; ++j) { zw[j] = *(const u32x4*)(zp + 8 * j); pw[j] = (u32x4){0u, 0u, 0u, 0u}; if (hasp) pw[j] = *(const u32x4*)(pp + 8 * j); }
#pragma unroll
      for (int j = 0; j < 8; ++j) { const float4 m = *(const float4*)(mup + 4 * j);
          const unsigned za = zw[j >> 1][2 * (j & 1)], zb = zw[j >> 1][2 * (j & 1) + 1], pa = pw[j >> 1][2 * (j & 1)], pb = pw[j >> 1][2 * (j & 1) + 1];
          const float4 z = {__uint_as_float(za << 16), __uint_as_float(za & 0xffff0000u), __uint_as_float(zb << 16), __uint_as_float(zb & 0xffff0000u)};
          const float4 p = {__uint_as_float(pa << 16), __uint_as_float(pa & 0xffff0000u), __uint_as_float(pb << 16), __uint_as_float(pb & 0xffff0000u)};
          float v0 = z.x + (p.x - z.x) * m.x, v1 = z.y + (p.y - z.y) * m.y, v2 = z.z + (p.z - z.z) * m.z, v3 = z.w + (p.w - z.w) * m.w;
          if (sub < 2) { v0 = tanh_f(v0); v1 = tanh_f(v1); v2 = tanh_f(v2); v3 = tanh_f(v3); } else if (sub >= 4) { v0 = sigmoid_f(v0); v1 = sigmoid_f(v1); v2 = sigmoid_f(v2); v3 = sigmoid_f(v3); }
          *(MK_LDS u32x2*)(lds + IN_OFF + r * 528 + (sub * 32 + 4 * j) * 2) = pack4(v0, v1, v2, v3); } }
    WG_SYNC();
    const int mt = wave & 3, nh = wave >> 2;
    f32x4 aw[2], aa[2], ag[2];
    { bf16x8 af[8];
#pragma unroll
      for (int s = 0; s < 8; ++s) af[s] = *(const MK_LDS bf16x8*)(lds + IN_OFF + (16 * mt + ln) * 528 + (32 * s + 8 * q) * 2);
#pragma unroll
      for (int nl = 0; nl < 2; ++nl) { aw[nl] = (f32x4){0.f, 0.f, 0.f, 0.f}; aa[nl] = aw[nl]; ag[nl] = aw[nl];
          const bf16_t* bp = lora + (size_t)(head * 64 + (2 * nh + nl) * 16 + ln) * 256 + 8 * q;
#pragma unroll
          for (int s = 0; s < 8; ++s) { const bf16x8 b = *(const bf16x8*)(bp + 32 * s);
              if (s < 2) aw[nl] = mfma16(af[s], b, aw[nl]); else if (s < 4) aa[nl] = mfma16(af[s], b, aa[nl]); else ag[nl] = mfma16(af[s], b, ag[nl]); } } }
    float rr[2][4], km[2][4], vz[2][4], kn[2][4], bb[2][4], ss[4] = {0.f, 0.f, 0.f, 0.f}, bn[4] = {0.f, 0.f, 0.f, 0.f};
    const int tb = 16 * mt + 4 * q;
    {
      float zr[2][4], zk[2][4], zv[2][4], pr[2][4], pk[2][4], pv[2][4], par[2][8];
#pragma unroll
      for (int nl = 0; nl < 2; ++nl) { const int C = head * 64 + 16 * (2 * nh + nl) + ln;
          par[nl][0] = mu[C]; par[nl][1] = mu[768 + C]; par[nl][2] = mu[1536 + C]; par[nl][3] = w0[C]; par[nl][4] = a0[C]; par[nl][5] = kkp[C]; par[nl][6] = kap[C]; par[nl][7] = rkp[C];
#pragma unroll
          for (int i = 0; i < 4; ++i) { const int row = R0 + tb + i; const bf16_t* zp = P + (size_t)row * NIN + O_RW + C; const bool hp = (row & (TP - 1)) != 0;
              zr[nl][i] = pbf(zp); zk[nl][i] = pbf(zp + 768); zv[nl][i] = pbf(zp + 1536);
              pr[nl][i] = hp ? pbf(zp - NIN) : 0.f; pk[nl][i] = hp ? pbf(zp + 768 - NIN) : 0.f; pv[nl][i] = hp ? pbf(zp + 1536 - NIN) : 0.f; } }
#pragma unroll
      for (int nl = 0; nl < 2; ++nl) { const int cc = 16 * (2 * nh + nl) + ln;
#pragma unroll
          for (int i = 0; i < 4; ++i) {
              const float r_ = zr[nl][i] + (pr[nl][i] - zr[nl][i]) * par[nl][0], kz = zk[nl][i] + (pk[nl][i] - zk[nl][i]) * par[nl][1], v_ = zv[nl][i] + (pv[nl][i] - zv[nl][i]) * par[nl][2];
              const float x = -(par[nl][3] + aw[nl][i]); const float sp = fmaxf(x, 0.f) + __logf(1.0f + __expf(-fabsf(x)));
              const float ldec = -__expf(-sp - 0.5f);
              const float aval = sigmoid_f(par[nl][4] + aa[nl][i]); const float kr = kz * par[nl][5], kmod = kz * (1.0f + (aval - 1.0f) * par[nl][6]);
              rr[nl][i] = r_; km[nl][i] = kmod; vz[nl][i] = v_; kn[nl][i] = kr; bb[nl][i] = aval; ss[i] += kr * kr; bn[i] += r_ * kmod * par[nl][7];
              LA[(tb + i) * 65 + cc] = ldec; } }
#pragma unroll
      for (int nl = 0; nl < 2; ++nl) { const int cc = 16 * (2 * nh + nl) + ln;
          *(MK_LDS u32x2*)(lds + S_TT * SL + cc * 144 + tb * 2) = pack4(ag[nl][0], ag[nl][1], ag[nl][2], ag[nl][3]); } }
#pragma unroll
    for (int i = 0; i < 4; ++i) { ss[i] = row16_sum(ss[i]); bn[i] = row16_sum(bn[i]); if (ln == 0) { XC[nh * 64 + tb + i] = ss[i]; XC[128 + nh * 64 + tb + i] = bn[i]; } }
    WG_SYNC();
    { const int cs = tid & 63, sg = tid >> 6; float pfx[8], run = 0.f;
#pragma unroll
      for (int j = 0; j < 8; ++j) { run += LA[(8 * sg + j) * 65 + cs]; pfx[j] = run; }
      XC[256 + sg * 64 + cs] = run;
      WG_SYNC();
      float off = 0.f;
#pragma unroll
      for (int s2 = 0; s2 < 7; ++s2) off += (s2 < sg) ? XC[256 + s2 * 64 + cs] : 0.f;
#pragma unroll
      for (int j = 0; j < 8; ++j) LA[(8 * sg + j) * 65 + cs] = off + pfx[j]; }
    WG_SYNC();
#pragma unroll
    for (int nl = 0; nl < 2; ++nl) {
        const int cc = 16 * (2 * nh + nl) + ln; const float lpC = LA[63 * 65 + cc];
        float o_kt[4], o_rt[4], o_bt[4], o_kq[4], o_kb[4], o_bb[4];
#pragma unroll
        for (int i = 0; i < 4; ++i) { const int t = tb + i; const float lp = LA[t * 65 + cc], lpm = t ? LA[(t - 1) * 65 + cc] : 0.f;
            const float tot = XC[t] + XC[64 + t]; const float kkn = kn[nl][i] * rsqrtf(fmaxf(tot, 1e-24f)), bv = kkn * bb[nl][i];
            const float e_m = __expf(lpm), e_p = __expf(lp), e_n = __expf(-lp), e_c = __expf(lpC - lp);
            o_kt[i] = kkn * e_m; o_rt[i] = rr[nl][i] * e_p; o_bt[i] = bv * e_n; o_kq[i] = km[nl][i] * e_n; o_kb[i] = km[nl][i] * e_c; o_bb[i] = bv * e_c;
            *(MK_LDS unsigned short*)(lds + S_KT * SL + t * 144 + cc * 2) = bf16_1(o_kt[i]); *(MK_LDS unsigned short*)(lds + S_RT * SL + t * 144 + cc * 2) = bf16_1(o_rt[i]);
            *(MK_LDS unsigned short*)(lds + S_BT * SL + t * 144 + cc * 2) = bf16_1(o_bt[i]); *(MK_LDS unsigned short*)(lds + S_KQ * SL + t * 144 + cc * 2) = bf16_1(o_kq[i]);
            if (t == 63) *(float*)(rec + RC_PC + cc * 4) = e_p; }
        *(MK_LDS u32x2*)(lds + S_KTT * SL + cc * 144 + tb * 2) = pack4(o_kt[0], o_kt[1], o_kt[2], o_kt[3]);
        *(MK_LDS u32x2*)(lds + S_VT * SL + cc * 144 + tb * 2) = pack4(vz[nl][0], vz[nl][1], vz[nl][2], vz[nl][3]);
        *(MK_LDS u32x2*)(lds + S_KBT * SL + cc * 144 + tb * 2) = pack4(o_kb[0], o_kb[1], o_kb[2], o_kb[3]);
        *(MK_LDS u32x2*)(lds + S_BBT * SL + cc * 144 + tb * 2) = pack4(o_bb[0], o_bb[1], o_bb[2], o_bb[3]);
    }
    if (nh == 0 && ln == 0) {
#pragma unroll
        for (int i = 0; i < 4; ++i) *(float*)(rec + RC_BO + (tb + i) * 4) = XC[128 + tb + i] + XC[192 + tb + i]; }
    WG_SYNC();
    { const int rr_ = tid >> 3, pc_ = (tid & 7) * 16;
      *(u32x4*)(rec + RC_KT + rr_ * 128 + pc_) = *(const MK_LDS u32x4*)(lds + S_KT * SL + rr_ * 144 + pc_);
      *(u32x4*)(rec + RC_VV + rr_ * 128 + pc_) = *(const MK_LDS u32x4*)(lds + S_VT * SL + rr_ * 144 + pc_);
      *(u32x4*)(rec + RC_GG + rr_ * 128 + pc_) = *(const MK_LDS u32x4*)(lds + S_TT * SL + rr_ * 144 + pc_); }
    { const int mi = mt;
      const bf16x8 fk0 = ldfrag(lds + S_KT * SL, mi, 0, ln, q), fk1 = ldfrag(lds + S_KT * SL, mi, 1, ln, q), fr0 = ldfrag(lds + S_RT * SL, mi, 0, ln, q), fr1 = ldfrag(lds + S_RT * SL, mi, 1, ln, q);
      bf16x8 fb[2][2], fq[2][2];
#pragma unroll
      for (int nl = 0; nl < 2; ++nl)
#pragma unroll
          for (int ks = 0; ks < 2; ++ks) { fb[nl][ks] = ldfrag(lds + S_BT * SL, 2 * nh + nl, ks, ln, q); fq[nl][ks] = ldfrag(lds + S_KQ * SL, 2 * nh + nl, ks, ln, q); }
      asm volatile("s_waitcnt lgkmcnt(0)" ::: "memory");
#pragma unroll
      for (int nl = 0; nl < 2; ++nl) { const int ni = 2 * nh + nl;
          f32x4 akb = {0.f, 0.f, 0.f, 0.f}, akk = akb, ark = akb, arb = akb;
          if (ni <= mi) {
              akb = mfma16(fk0, fb[nl][0], akb); akk = mfma16(fk0, fq[nl][0], akk); ark = mfma16(fq[nl][0], fr0, ark); arb = mfma16(fb[nl][0], fr0, arb);
              akb = mfma16(fk1, fb[nl][1], akb); akk = mfma16(fk1, fq[nl][1], akk); ark = mfma16(fq[nl][1], fr1, ark); arb = mfma16(fb[nl][1], fr1, arb); }
          { const int s = 16 * ni + ln;
            float kkv[4];
#pragma unroll
            for (int i = 0; i < 4; ++i) { const int t = 16 * mi + 4 * q + i; LA[t * 65 + s] = (s < t) ? akb[i] : 0.f; kkv[i] = (s < t) ? akk[i] : 0.f; }
            *(MK_LDS u32x2*)(lds + S_AKKT * SL + s * 144 + (16 * mi + 4 * q) * 2) = pack4(kkv[0], kkv[1], kkv[2], kkv[3]); }
          { const int t = 16 * mi + ln, s0 = 16 * ni + 4 * q;
            *(MK_LDS u32x2*)(lds + S_ARK * SL + t * 144 + s0 * 2) = pack4(s0 <= t ? ark[0] : 0.f, s0 + 1 <= t ? ark[1] : 0.f, s0 + 2 <= t ? ark[2] : 0.f, s0 + 3 <= t ? ark[3] : 0.f);
            *(MK_LDS u32x2*)(lds + S_ARB * SL + t * 144 + s0 * 2) = pack4(s0 <= t ? arb[0] : 0.f, s0 + 1 <= t ? arb[1] : 0.f, s0 + 2 <= t ? arb[2] : 0.f, s0 + 3 <= t ? arb[3] : 0.f); } } }
    WG_SYNC();
    if (wave == 0) { const int o = 16 * q, j = ln; float Tc[16];
#pragma unroll
        for (int p4 = 0; p4 < 4; ++p4) { float Lr[4][16];
#pragma unroll
            for (int rr = 0; rr < 4; ++rr)
#pragma unroll
                for (int e = 0; e < 16; ++e) Lr[rr][e] = (e < 4 * p4 + rr) ? LA[(o + 4 * p4 + rr) * 65 + o + e] : 0.f;
#pragma unroll
            for (int rr = 0; rr < 4; ++rr) { const int r = 4 * p4 + rr; float acc = (r == j) ? 1.0f : 0.f;
#pragma unroll
                for (int e = 0; e < 16; ++e) if (e < r) acc -= (e >= j) ? Lr[rr][e] * Tc[e] : 0.f;
                Tc[r] = (r >= j) ? acc : 0.f; } }
        __builtin_amdgcn_wave_barrier();
#pragma unroll
        for (int r = 0; r < 16; ++r) LA[(o + r) * 65 + o + j] = Tc[r]; }
    WG_SYNC();
#pragma unroll
    for (int bi = 1; bi < 4; ++bi) {
        const int col = lane, r0 = 2 * wave; float x0 = 0.f, x1 = 0.f; const bool act = col < 16 * bi;
        if (act) {
#pragma unroll
            for (int sb = 0; sb < bi; ++sb) { float tv[16], l0[16], l1[16];
#pragma unroll
                for (int e = 0; e < 16; ++e) { const int s = 16 * sb + e; tv[e] = LA[s * 65 + col]; l0[e] = LA[(16 * bi + r0) * 65 + s]; l1[e] = LA[(16 * bi + r0 + 1) * 65 + s]; }
#pragma unroll
                for (int e = 0; e < 16; ++e) { x0 += l0[e] * tv[e]; x1 += l1[e] * tv[e]; } } }
        WG_SYNC();
        if (act) { LA[(16 * bi + r0) * 65 + col] = x0; LA[(16 * bi + r0 + 1) * 65 + col] = x1; }
        WG_SYNC();
        float t0 = 0.f, t1 = 0.f;
        if (act) { float xv[16], d0[16], d1[16];
#pragma unroll
            for (int e = 0; e < 16; ++e) { xv[e] = LA[(16 * bi + e) * 65 + col]; d0[e] = LA[(16 * bi + r0) * 65 + 16 * bi + e]; d1[e] = LA[(16 * bi + r0 + 1) * 65 + 16 * bi + e]; }
#pragma unroll
            for (int e = 0; e < 16; ++e) { t0 -= d0[e] * xv[e]; t1 -= d1[e] * xv[e]; } }
        WG_SYNC();
        if (act) { LA[(16 * bi + r0) * 65 + col] = t0; LA[(16 * bi + r0 + 1) * 65 + col] = t1; }
        WG_SYNC();
    }
    { const int t = tid >> 3, s0 = (tid & 7) * 8; float tv[8];
#pragma unroll
      for (int j = 0; j < 8; ++j) { const int s = s0 + j; tv[j] = (s <= t) ? LA[t * 65 + s] : 0.f; *(MK_LDS unsigned short*)(lds + S_TT * SL + s * 144 + t * 2) = bf16_1(tv[j]); }
      *(MK_LDS u32x2*)(lds + S_TM * SL + t * 144 + s0 * 2) = pack4(tv[0], tv[1], tv[2], tv[3]); *(MK_LDS u32x2*)(lds + S_TM * SL + t * 144 + (s0 + 4) * 2) = pack4(tv[4], tv[5], tv[6], tv[7]); }
    WG_SYNC();
    { const int mi = mt;
      bf16x8 ftm[2], farb[2], fttm[2], fakk[2][2], fttn[2][2], fbb[2][2];
#pragma unroll
      for (int ks = 0; ks < 2; ++ks) { ftm[ks] = ldfrag(lds + S_TM * SL, mi, ks, ln, q); farb[ks] = ldfrag(lds + S_ARB * SL, mi, ks, ln, q); fttm[ks] = ldfrag(lds + S_TT * SL, mi, ks, ln, q);
#pragma unroll
          for (int nl = 0; nl < 2; ++nl) { fakk[nl][ks] = ldfrag(lds + S_AKKT * SL, 2 * nh + nl, ks, ln, q); fttn[nl][ks] = ldfrag(lds + S_TT * SL, 2 * nh + nl, ks, ln, q); fbb[nl][ks] = ldfrag(lds + S_BBT * SL, 2 * nh + nl, ks, ln, q); } }
      asm volatile("s_waitcnt lgkmcnt(0)" ::: "memory");
      WG_SYNC();
#pragma unroll
      for (int nl = 0; nl < 2; ++nl) { const int ni = 2 * nh + nl;
          f32x4 w = {0.f, 0.f, 0.f, 0.f}, g = w, z = w;
#pragma unroll
          for (int ks = 0; ks < 2; ++ks) {
              w = mfma16(fakk[nl][ks], ftm[ks], w);
              g = mfma16(fttn[nl][ks], farb[ks], g);
              z = mfma16(fttm[ks], fbb[nl][ks], z); }
          *(u32x2*)(rec + RC_ZT + ((16 * ni + ln) * 64 + 16 * mi + 4 * q) * 2) = pack4(z[0], z[1], z[2], z[3]);
          *(MK_LDS u32x2*)(lds + S_W * SL + (16 * mi + ln) * 144 + (16 * ni + 4 * q) * 2) = pack4(w[0], w[1], w[2], w[3]);
          *(MK_LDS u32x2*)(lds + S_G * SL + (16 * mi + ln) * 144 + (16 * ni + 4 * q) * 2) = pack4(g[0], g[1], g[2], g[3]); } }
    WG_SYNC();
    { const int mi = mt;
      bf16x8 fw[2], fg[2], fvt[2][2], fktt[2][2]; u32x2 rtv[2];
#pragma unroll
      for (int ks = 0; ks < 2; ++ks) { fw[ks] = ldfrag(lds + S_W * SL, mi, ks, ln, q); fg[ks] = ldfrag(lds + S_G * SL, mi, ks, ln, q);
#pragma unroll
          for (int nl = 0; nl < 2; ++nl) { fvt[nl][ks] = ldfrag(lds + S_VT * SL, 2 * nh + nl, ks, ln, q); fktt[nl][ks] = ldfrag(lds + S_KTT * SL, 2 * nh + nl, ks, ln, q); } }
#pragma unroll
      for (int nl = 0; nl < 2; ++nl) rtv[nl] = *(const MK_LDS u32x2*)(lds + S_RT * SL + (16 * mi + ln) * 144 + (16 * (2 * nh + nl) + 4 * q) * 2);
      asm volatile("s_waitcnt lgkmcnt(0)" ::: "memory");
#pragma unroll
      for (int nl = 0; nl < 2; ++nl) { const int ni = 2 * nh + nl;
          f32x4 u = {0.f, 0.f, 0.f, 0.f}, gk = u;
#pragma unroll
          for (int ks = 0; ks < 2; ++ks) {
              u = mfma16(fw[ks], fvt[nl][ks], u);
              gk = mfma16(fktt[nl][ks], fg[ks], gk); }
          *(MK_LDS u32x2*)(lds + S_U0T * SL + (16 * ni + ln) * 144 + (16 * mi + 4 * q) * 2) = pack4(u[0], u[1], u[2], u[3]);
          const int t = 16 * mi + ln, k0 = 16 * ni + 4 * q;
          const float r0 = __uint_as_float(rtv[nl].x << 16), r1 = __uint_as_float(rtv[nl].x & 0xffff0000u), r2 = __uint_as_float(rtv[nl].y << 16), r3 = __uint_as_float(rtv[nl].y & 0xffff0000u);
          *(u32x2*)(rec + RC_RH + (t * 64 + k0) * 2) = pack4(r0 - gk[0], r1 - gk[1], r2 - gk[2], r3 - gk[3]); } }
    WG_SYNC();
    { const int mi = mt;
      bf16x8 fark[2], farb[2], fvm[2], fum[2], fvn[2][2], fun[2][2], fkb[2][2], fbb[2][2];
#pragma unroll
      for (int ks = 0; ks < 2; ++ks) { fark[ks] = ldfrag(lds + S_ARK * SL, mi, ks, ln, q); farb[ks] = ldfrag(lds + S_ARB * SL, mi, ks, ln, q); fvm[ks] = ldfrag(lds + S_VT * SL, mi, ks, ln, q); fum[ks] = ldfrag(lds + S_U0T * SL, mi, ks, ln, q);
#pragma unroll
          for (int nl = 0; nl < 2; ++nl) { const int ni = 2 * nh + nl; fvn[nl][ks] = ldfrag(lds + S_VT * SL, ni, ks, ln, q); fun[nl][ks] = ldfrag(lds + S_U0T * SL, ni, ks, ln, q); fkb[nl][ks] = ldfrag(lds + S_KBT * SL, ni, ks, ln, q); fbb[nl][ks] = ldfrag(lds + S_BBT * SL, ni, ks, ln, q); } }
      asm volatile("s_waitcnt lgkmcnt(0)" ::: "memory");
#pragma unroll
      for (int nl = 0; nl < 2; ++nl) { const int ni = 2 * nh + nl;
          f32x4 y1 = {0.f, 0.f, 0.f, 0.f}, y2 = y1, n1 = y1, n2 = y1;
#pragma unroll
          for (int ks = 0; ks < 2; ++ks) {
              y1 = mfma16(fark[ks], fvn[nl][ks], y1);
              y2 = mfma16(farb[ks], fun[nl][ks], y2);
              n1 = mfma16(fkb[nl][ks], fvm[ks], n1);
              n2 = mfma16(fbb[nl][ks], fum[ks], n2); }
          { const f32x4 yy = y1 - y2; *(u32x2*)(rec + RC_Y0 + ((mi * 4 + ni) * 64 + lane) * 8) = pack4(yy[0], yy[1], yy[2], yy[3]); }
          { const f32x4 nd = n1 - n2; *(u32x2*)(rec + RC_N + ((mi * 4 + ni) * 64 + lane) * 8) = pack4(nd[0], nd[1], nd[2], nd[3]); } } }
    WG_SYNC();
}

constexpr int SB_S = 0, SB_W1 = SL;
__device__ __forceinline__ void rwkv_chunk_b(const Args& a, int l, int n, int head, MK_LDS unsigned char* lds) {
    const int tid = otid(), lane = tid & 63, wave = tid >> 6, ln = lane & 15, q = lane >> 4;
    const int vi = wave & 3, kh = wave >> 2;
    f32x4 S[2]; S[0] = (f32x4){0.f, 0.f, 0.f, 0.f}; S[1] = S[0];
    unsigned char* rec0 = a.ws + WS_RWC + (size_t)((n * 12 + head) * 32) * RC_BYTES;
    bf16x8 fkA[2][2], fzA[2][2], fkB[2][2], fzB[2][2]; u32x2 nnA[2], nnB[2]; f32x4 pcA[2], pcB[2];
#define RB_LOAD_K(fk, rec) do { _Pragma("unroll") for (int kl = 0; kl < 2; ++kl) { const int tk = 2 * kh + kl; _Pragma("unroll") for (int ks = 0; ks < 2; ++ks) \
        fk[kl][ks] = *(const bf16x8*)((rec) + RC_KT + ((16 * tk + ln) * 64 + 32 * ks + 8 * q) * 2); } } while (0)
#define RB_LOAD_Z(fz, nn, pc, rec) do { _Pragma("unroll") for (int kl = 0; kl < 2; ++kl) { const int tk = 2 * kh + kl; _Pragma("unroll") for (int ks = 0; ks < 2; ++ks) \
        fz[kl][ks] = *(const bf16x8*)((rec) + RC_ZT + ((16 * tk + ln) * 64 + 32 * ks + 8 * q) * 2); \
        nn[kl] = *(const u32x2*)((rec) + RC_N + ((vi * 4 + tk) * 64 + lane) * 8); pc[kl] = *(const f32x4*)((rec) + RC_PC + (16 * tk + 4 * q) * 4); } } while (0)
#define RB_STEP(fk, fz, nn, pc, c) do { unsigned char* rec = rec0 + (size_t)(c) * RC_BYTES; \
          \
        _Pragma("unroll") for (int kl = 0; kl < 2; ++kl) { const u32x2 pk = pack4(S[kl][0], S[kl][1], S[kl][2], S[kl][3]); \
            *(MK_LDS u32x2*)(lds + SB_S + (16 * vi + ln) * 144 + (16 * (2 * kh + kl) + 4 * q) * 2) = pk; \
            *(u32x2*)(rec + RC_ST + ((16 * vi + ln) * 64 + 16 * (2 * kh + kl) + 4 * q) * 2) = pk; } \
        WG_SYNC(); \
          \
        _Pragma("unroll") for (int kl = 0; kl < 2; ++kl) { const int ti = 2 * kh + kl; f32x4 w = {0.f, 0.f, 0.f, 0.f}; \
            _Pragma("unroll") for (int ks = 0; ks < 2; ++ks) w = mfma16(fk[kl][ks], ldfrag(lds + SB_S, vi, ks, ln, q), w); \
            *(MK_LDS u32x2*)(lds + SB_W1 + (16 * vi + ln) * 144 + (16 * ti + 4 * q) * 2) = pack4(w[0], w[1], w[2], w[3]); } \
        if ((c) + 2 < 32) RB_LOAD_K(fk, rec + 2 * RC_BYTES); \
        WG_SYNC(); \
          \
        _Pragma("unroll") for (int kl = 0; kl < 2; ++kl) { f32x4 wz = {0.f, 0.f, 0.f, 0.f}; \
            _Pragma("unroll") for (int ks = 0; ks < 2; ++ks) wz = mfma16(fz[kl][ks], ldfrag(lds + SB_W1, vi, ks, ln, q), wz); \
            S[kl] = S[kl] * pc[kl] - wz + (f32x4){__uint_as_float(nn[kl].x << 16), __uint_as_float(nn[kl].x & 0xffff0000u), __uint_as_float(nn[kl].y << 16), __uint_as_float(nn[kl].y & 0xffff0000u)}; } \
        if ((c) + 2 < 32) RB_LOAD_Z(fz, nn, pc, rec + 2 * RC_BYTES); } while (0)
    RB_LOAD_K(fkA, rec0); RB_LOAD_Z(fzA, nnA, pcA, rec0); RB_LOAD_K(fkB, rec0 + RC_BYTES); RB_LOAD_Z(fzB, nnB, pcB, rec0 + RC_BYTES);
#pragma unroll
    for (int c = 0; c < 32; c += 2) { RB_STEP(fkA, fzA, nnA, pcA, c); RB_STEP(fkB, fzB, nnB, pcB, c + 1); }
#undef RB_STEP
#undef RB_LOAD_K
#undef RB_LOAD_Z
    float* so = a.out + O_WKV_P + (size_t)((l * 4 + n) * 12 + head) * 4096;
#pragma unroll
    for (int kl = 0; kl < 2; ++kl) *(f32x4*)(so + (16 * vi + ln) * 64 + 16 * (2 * kh + kl) + 4 * q) = S[kl];
    WG_SYNC();
}
__device__ __forceinline__ void rwkv_chunk_c_wave(const Args& a, int l, int wt) {
    const int lane = otid() & 63, ln = lane & 15, q = lane >> 4;
    const int ti = wt & 3, ch = wt >> 2, c = ch & 31, nh = ch >> 5, head = nh % 12, n = nh / 12;
    const unsigned char* rec = a.ws + WS_RWC + (size_t)ch * RC_BYTES;
    const float* lnw = inp(a, I_LNW) + l * 768 + head * 64; const float* lnb = inp(a, I_LNB) + l * 768 + head * 64;
    bf16_t* MIX = (bf16_t*)(a.ws + WS_MIX);
    const bf16x8 fr0 = *(const bf16x8*)(rec + RC_RH + ((16 * ti + ln) * 64 + 8 * q) * 2), fr1 = *(const bf16x8*)(rec + RC_RH + ((16 * ti + ln) * 64 + 32 + 8 * q) * 2);
    f32x4 y[4]; float bo[4], vv[4][4], gg[4][4];
#pragma unroll
    for (int vt = 0; vt < 4; ++vt) { { const u32x2 yw = *(const u32x2*)(rec + RC_Y0 + ((ti * 4 + vt) * 64 + lane) * 8); y[vt] = (f32x4){__uint_as_float(yw.x << 16), __uint_as_float(yw.x & 0xffff0000u), __uint_as_float(yw.y << 16), __uint_as_float(yw.y & 0xffff0000u)}; }
        const bf16x8 s0 = *(const bf16x8*)(rec + RC_ST + ((16 * vt + ln) * 64 + 8 * q) * 2), s1 = *(const bf16x8*)(rec + RC_ST + ((16 * vt + ln) * 64 + 32 + 8 * q) * 2);
        y[vt] = mfma16(fr0, s0, y[vt]); y[vt] = mfma16(fr1, s1, y[vt]);
        { const int cc = 16 * vt + ln; const u32x2 pv = *(const u32x2*)(rec + RC_VV + (cc * 64 + 16 * ti + 4 * q) * 2), pg = *(const u32x2*)(rec + RC_GG + (cc * 64 + 16 * ti + 4 * q) * 2);
          vv[vt][0] = __uint_as_float(pv.x << 16); vv[vt][1] = __uint_as_float(pv.x & 0xffff0000u); vv[vt][2] = __uint_as_float(pv.y << 16); vv[vt][3] = __uint_as_float(pv.y & 0xffff0000u);
          gg[vt][0] = __uint_as_float(pg.x << 16); gg[vt][1] = __uint_as_float(pg.x & 0xffff0000u); gg[vt][2] = __uint_as_float(pg.y << 16); gg[vt][3] = __uint_as_float(pg.y & 0xffff0000u); } }
#pragma unroll
    for (int i = 0; i < 4; ++i) bo[i] = *(const float*)(rec + RC_BO + (16 * ti + 4 * q + i) * 4);
#pragma unroll
    for (int i = 0; i < 4; ++i) { const int t = 16 * ti + 4 * q + i;
        float sm = (y[0][i] + y[1][i]) + (y[2][i] + y[3][i]); sm = row16_sum(sm); const float mean = sm * (1.0f / 64.0f);
        const float d0 = y[0][i] - mean, d1 = y[1][i] - mean, d2 = y[2][i] - mean, d3 = y[3][i] - mean; float vs = (d0 * d0 + d1 * d1) + (d2 * d2 + d3 * d3); vs = row16_sum(vs);
        const float rs = rsqrtf(vs * (1.0f / 64.0f) + 64e-5f); const float dd[4] = {d0, d1, d2, d3};
#pragma unroll
        for (int vt = 0; vt < 4; ++vt) { const int cc = 16 * vt + ln;
            MIX[(size_t)(n * TP + c * 64 + t) * D + 512 + head * 64 + cc] = bf16_1((dd[vt] * rs * lnw[cc] + lnb[cc] + bo[i] * vv[vt][i]) * gg[vt][i]); } }
}
}

namespace mk {
constexpr int HC_QP = 0, HC_OI = 16384, HC_UT = 49152, HC_EC = 114688, HC_ST = 115200, HC_BYTES = 147968;
constexpr int HL_QT = 0, HL_KT = 17408, HL_KBT = 34816, HL_VT = 53248, HL_ATT = 71680, HL_XS = 80896;
__device__ __forceinline__ bf16x8 ldfrag272(const MK_LDS unsigned char* base, int tile, int ks, int ln, int q) { return *(const MK_LDS bf16x8*)(base + (16 * tile + ln) * 272 + (32 * ks + 8 * q) * 2); }

__device__ __forceinline__ void hgrn_chunk_a(const Args& a, int l, int n, int head, int c, MK_LDS unsigned char* lds) {
    const int tid = otid(), lane = tid & 63, wave = tid >> 6, ln = lane & 15, q = lane >> 4;
    const bf16_t* P = (const bf16_t*)(a.ws + WS_P);
    unsigned char* rec = a.ws + WS_HGC + (size_t)((n * 6 + head) * 32 + c) * HC_BYTES;
    const int R0 = n * TP + c * 64;
    MK_LDS float* XS = (MK_LDS float*)(lds + HL_XS);
    {
      const int kc = tid & 127, sg = tid >> 7, C = head * 128 + kc;
      float lbv; { const float* lbr = inp(a, I_LBRAW); const float r0 = lbr[C], r1 = lbr[768 + C], r2 = lbr[1536 + C], r3 = lbr[2304 + C];
          const float mx = fmaxf(fmaxf(r0, r1), fmaxf(r2, r3)), e0 = expf(r0 - mx), e1 = expf(r1 - mx), e2 = expf(r2 - mx), e3 = expf(r3 - mx), inv = 1.0f / (e0 + e1 + e2 + e3);
          lbv = (l == 0 ? 0.f : l == 1 ? e1 : l == 2 ? e1 + e2 : e1 + e2 + e3) * inv; }
      float qv[16], kv[16], bv[16], vv[16], run = 0.f;
#pragma unroll
      for (int j = 0; j < 16; ++j) { const bf16_t* rp = P + (size_t)(R0 + 16 * sg + j) * NIN + O_HG + C;
          const float qq = pbf(rp), ff = pbf(rp + 768); vv[j] = pbf(rp + 1536);
          const float fg = lbv + (1.0f - lbv) * sigmoid_f(ff); qv[j] = silu_f(qq); kv[j] = 1.0f - fg; run += __logf(fg); bv[j] = run; }
      XS[sg * 128 + kc] = run;
      WG_SYNC();
      const float s0 = XS[kc], s1 = XS[128 + kc], s2 = XS[256 + kc], s3 = XS[384 + kc];
      const float off = sg == 0 ? 0.f : sg == 1 ? s0 : sg == 2 ? s0 + s1 : s0 + s1 + s2, bref = s0 + s1, bC = (s0 + s1) + (s2 + s3);
      float kb[16];
#pragma unroll
      for (int j = 0; j < 16; ++j) { const int t = 16 * sg + j; const float b = off + bv[j];
          *(unsigned short*)(rec + HC_QP + (t * 128 + kc) * 2) = bf16_1(qv[j] * __expf(b));
          *(MK_LDS unsigned short*)(lds + HL_QT + t * 272 + kc * 2) = bf16_1(qv[j] * __expf(b - bref));
          *(MK_LDS unsigned short*)(lds + HL_KT + t * 272 + kc * 2) = bf16_1(kv[j] * __expf(bref - b));
          kb[j] = kv[j] * __expf(bC - b); }
      *(MK_LDS u32x4*)(lds + HL_KBT + kc * 144 + (16 * sg) * 2) = (u32x4){cvt_pk_bf16(kb[0], kb[1]), cvt_pk_bf16(kb[2], kb[3]), cvt_pk_bf16(kb[4], kb[5]), cvt_pk_bf16(kb[6], kb[7])};
      *(MK_LDS u32x4*)(lds + HL_KBT + kc * 144 + (16 * sg + 8) * 2) = (u32x4){cvt_pk_bf16(kb[8], kb[9]), cvt_pk_bf16(kb[10], kb[11]), cvt_pk_bf16(kb[12], kb[13]), cvt_pk_bf16(kb[14], kb[15])};
      *(MK_LDS u32x4*)(lds + HL_VT + kc * 144 + (16 * sg) * 2) = (u32x4){cvt_pk_bf16(vv[0], vv[1]), cvt_pk_bf16(vv[2], vv[3]), cvt_pk_bf16(vv[4], vv[5]), cvt_pk_bf16(vv[6], vv[7])};
      *(MK_LDS u32x4*)(lds + HL_VT + kc * 144 + (16 * sg + 8) * 2) = (u32x4){cvt_pk_bf16(vv[8], vv[9]), cvt_pk_bf16(vv[10], vv[11]), cvt_pk_bf16(vv[12], vv[13]), cvt_pk_bf16(vv[14], vv[15])};
      if (sg == 0) *(float*)(rec + HC_EC + kc * 4) = __expf(bC); }
    WG_SYNC();
    { const int mi = wave & 3, nh = wave >> 2;
#pragma unroll
      for (int nl = 0; nl < 2; ++nl) { const int ni = 2 * nh + nl; f32x4 at = {0.f, 0.f, 0.f, 0.f};
          if (ni <= mi) {
#pragma unroll
              for (int ks = 0; ks < 4; ++ks) at = mfma16(ldfrag272(lds + HL_KT, ni, ks, ln, q), ldfrag272(lds + HL_QT, mi, ks, ln, q), at); }
          const int t = 16 * mi + ln, s0 = 16 * ni + 4 * q;
          *(MK_LDS u32x2*)(lds + HL_ATT + t * 144 + s0 * 2) = pack4(s0 <= t ? at[0] : 0.f, s0 + 1 <= t ? at[1] : 0.f, s0 + 2 <= t ? at[2] : 0.f, s0 + 3 <= t ? at[3] : 0.f); } }
    WG_SYNC();
    { const int ti = wave & 3, vh = wave >> 2;
      const bf16x8 fa0 = ldfrag(lds + HL_ATT, ti, 0, ln, q), fa1 = ldfrag(lds + HL_ATT, ti, 1, ln, q);
#pragma unroll
      for (int vl = 0; vl < 4; ++vl) { const int vi = 4 * vh + vl; f32x4 o = {0.f, 0.f, 0.f, 0.f};
          o = mfma16(fa0, ldfrag(lds + HL_VT, vi, 0, ln, q), o); o = mfma16(fa1, ldfrag(lds + HL_VT, vi, 1, ln, q), o);
          *(u32x2*)(rec + HC_OI + ((ti * 8 + vi) * 64 + lane) * 8) = pack4(o[0], o[1], o[2], o[3]); }
      const int vi = wave; const bf16x8 fv0 = ldfrag(lds + HL_VT, vi, 0, ln, q), fv1 = ldfrag(lds + HL_VT, vi, 1, ln, q);
#pragma unroll
      for (int ki = 0; ki < 8; ki += 2) { f32x4 u0 = {0.f, 0.f, 0.f, 0.f}, u1 = u0;
          u0 = mfma16(ldfrag(lds + HL_KBT, ki, 0, ln, q), fv0, u0); u0 = mfma16(ldfrag(lds + HL_KBT, ki, 1, ln, q), fv1, u0);
          u1 = mfma16(ldfrag(lds + HL_KBT, ki + 1, 0, ln, q), fv0, u1); u1 = mfma16(ldfrag(lds + HL_KBT, ki + 1, 1, ln, q), fv1, u1);
          u32x2 a = pack4(u0[0], u0[1], u0[2], u0[3]), b = pack4(u1[0], u1[1], u1[2], u1[3]);
          { const auto t = __builtin_amdgcn_permlane16_swap(a.x, b.x, false, false); a.x = t[0]; b.x = t[1]; }
          { const auto t = __builtin_amdgcn_permlane16_swap(a.y, b.y, false, false); a.y = t[0]; b.y = t[1]; }
          const int ko = (q & 1) ? 16 * (ki + 1) + 4 * (q - 1) : 16 * ki + 4 * q;
          *(u32x4*)(rec + HC_UT + ((16 * vi + ln) * 128 + ko) * 2) = (u32x4){a.x, a.y, b.x, b.y}; } }
    WG_SYNC();
}
__device__ __forceinline__ void hgrn_chunk_b(const Args& a, int l, int n, int head, int part) {
    const int tid = otid(), v = 16 * part + (tid >> 5), k4 = (tid & 31) * 4;
    unsigned char* rec0 = a.ws + WS_HGC + (size_t)((n * 6 + head) * 32) * HC_BYTES;
    f32x4 S = {0.f, 0.f, 0.f, 0.f};
    for (int c0 = 0; c0 < 32; c0 += 8) {
        f32x4 U[8], E[8];
#pragma unroll
        for (int j = 0; j < 8; ++j) { const unsigned char* rec = rec0 + (size_t)(c0 + j) * HC_BYTES; { const u32x2 uw = *(const u32x2*)(rec + HC_UT + (v * 128 + k4) * 2); U[j] = (f32x4){__uint_as_float(uw.x << 16), __uint_as_float(uw.x & 0xffff0000u), __uint_as_float(uw.y << 16), __uint_as_float(uw.y & 0xffff0000u)}; } E[j] = *(const f32x4*)(rec + HC_EC + k4 * 4); }
#pragma unroll
        for (int j = 0; j < 8; ++j) { unsigned char* rec = rec0 + (size_t)(c0 + j) * HC_BYTES;
            *(u32x2*)(rec + HC_ST + (v * 128 + k4) * 2) = pack4(S[0], S[1], S[2], S[3]);
            S = E[j] * S + U[j]; }
    }
    float* so = a.out + O_HGRN_P + (size_t)((l * 4 + n) * 6 + head) * 16384;
#pragma unroll
    for (int i = 0; i < 4; ++i) so[(size_t)(k4 + i) * 128 + v] = S[i];
}
__device__ __forceinline__ void hgrn_chunk_c(const Args& a, int l, int n, int head, int c, MK_LDS unsigned char* lds) {
    const int tid = otid(), lane = tid & 63, wave = tid >> 6, ln = lane & 15, q = lane >> 4;
    const bf16_t* P = (const bf16_t*)(a.ws + WS_P); bf16_t* MIX = (bf16_t*)(a.ws + WS_MIX);
    const unsigned char* rec = a.ws + WS_HGC + (size_t)((n * 6 + head) * 32 + c) * HC_BYTES;
    const float* hnw = inp(a, I_HNW) + l * 768 + head * 128;
    MK_LDS float* XS = (MK_LDS float*)lds;
    const int ti = wave & 3, vh = wave >> 2, R0 = n * TP + c * 64;
    bf16x8 fq[4];
#pragma unroll
    for (int ks = 0; ks < 4; ++ks) fq[ks] = *(const bf16x8*)(rec + HC_QP + ((16 * ti + ln) * 128 + 32 * ks + 8 * q) * 2);
    f32x4 o[4]; float ssq[4] = {0.f, 0.f, 0.f, 0.f};
#pragma unroll
    for (int vl = 0; vl < 4; ++vl) { const int vi = 4 * vh + vl; { const u32x2 ow = *(const u32x2*)(rec + HC_OI + ((ti * 8 + vi) * 64 + lane) * 8); o[vl] = (f32x4){__uint_as_float(ow.x << 16), __uint_as_float(ow.x & 0xffff0000u), __uint_as_float(ow.y << 16), __uint_as_float(ow.y & 0xffff0000u)}; }
#pragma unroll
        for (int ks = 0; ks < 4; ++ks) o[vl] = mfma16(fq[ks], *(const bf16x8*)(rec + HC_ST + ((16 * vi + ln) * 128 + 32 * ks + 8 * q) * 2), o[vl]);
#pragma unroll
        for (int i = 0; i < 4; ++i) ssq[i] += o[vl][i] * o[vl][i]; }
#pragma unroll
    for (int i = 0; i < 4; ++i) { ssq[i] = row16_sum(ssq[i]); if (ln == 0) XS[vh * 64 + 16 * ti + 4 * q + i] = ssq[i]; }
    WG_SYNC();
#pragma unroll
    for (int i = 0; i < 4; ++i) { const int t = 16 * ti + 4 * q + i; const float rs = rsqrtf((XS[t] + XS[64 + t]) * (1.0f / 128.0f) + 1e-5f);
        const bf16_t* gp = P + (size_t)(R0 + t) * NIN + O_HG + 2304 + head * 128;
#pragma unroll
        for (int vl = 0; vl < 4; ++vl) { const int vv = 16 * (4 * vh + vl) + ln;
            MIX[(size_t)(R0 + t) * D + 1280 + head * 128 + vv] = bf16_1(o[vl][i] * rs * hnw[vv] * silu_f(pbf(gp + vv))); } }
    WG_SYNC();
}
}
namespace mk {
typedef float f32x2 __attribute__((ext_vector_type(2)));
__device__ __forceinline__ void rwkv_sample_wave(const Args& a, int l, int task, MK_LDS float* wl  ) {
    const int lane = otid() & 63, seq = task / 12, head = task % 12, row0 = NPR + seq * 8;
    const float* RWB = (const float*)(a.ws + WS_RW); const float* BON = (const float*)(a.ws + WS_BONUS); bf16_t* MIX = (bf16_t*)(a.ws + WS_MIX);
#pragma unroll
    for (int i = 0; i < 14; ++i) { const int e = lane + 64 * i, step = e / 112, o4 = e - step * 112;
        *(MK_LDS f32x4*)(wl + step * 452 + 4 * o4) = *(const f32x4*)(RWB + ((size_t)(row0 + step) * 12 + head) * 448 + 4 * o4); }
    if (lane < 8) wl[lane * 452 + 448] = BON[(size_t)(row0 + lane) * 12 + head];
    const size_t so = (size_t)((l * 128 + seq) * 12 + head) * 4096 + lane * 64;
    f32x2 S[32];
    { const f32x4* s0 = (const f32x4*)(inp(a, I_WKV) + so);
#pragma unroll
      for (int j = 0; j < 16; ++j) { const f32x4 t = s0[j]; S[2 * j] = t.xy; S[2 * j + 1] = t.zw; } }
    __builtin_amdgcn_wave_barrier(); asm volatile("s_waitcnt lgkmcnt(0)" ::: "memory");
    const int C = head * 64 + lane; const float lw = inp(a, I_LNW)[l * 768 + C], lb = inp(a, I_LNB)[l * 768 + C];
    for (int t = 0; t < 8; ++t) { const MK_LDS float* B = wl + t * 452;
        f32x2 da = {0.f, 0.f}, db = {0.f, 0.f};
#pragma unroll
        for (int j = 0; j < 16; ++j) { const f32x4 kk = *(const MK_LDS f32x4*)(B + 256 + 4 * j); da += S[2 * j] * kk.xy; db += S[2 * j + 1] * kk.zw; }
        const float sa = -((da.x + da.y) + (db.x + db.y)), vv = B[128 + lane];
        const f32x2 sa2 = {sa, sa}, vv2 = {vv, vv};
        f32x2 ya = {0.f, 0.f}, yb = {0.f, 0.f};
#pragma unroll
        for (int j = 0; j < 16; ++j) { const f32x4 dd = *(const MK_LDS f32x4*)(B + 192 + 4 * j), bb = *(const MK_LDS f32x4*)(B + 320 + 4 * j), kv = *(const MK_LDS f32x4*)(B + 64 + 4 * j), rr = *(const MK_LDS f32x4*)(B + 4 * j);
            S[2 * j] = S[2 * j] * dd.xy + (sa2 * bb.xy + vv2 * kv.xy); S[2 * j + 1] = S[2 * j + 1] * dd.zw + (sa2 * bb.zw + vv2 * kv.zw);
            ya += S[2 * j] * rr.xy; yb += S[2 * j + 1] * rr.zw; }
        const float y = (ya.x + ya.y) + (yb.x + yb.y);
        const float mean = wave_sum(y) * (1.0f / 64.0f), dv = y - mean, var = wave_sum(dv * dv) * (1.0f / 64.0f);
        const size_t row = row0 + t; const float gg = B[384 + lane];
        MIX[row * D + 512 + C] = bf16_1((dv * rsqrtf(var + 64e-5f) * lw + lb + B[448] * vv) * gg);
    }
    { f32x4* o = (f32x4*)(a.out + O_WKV_S + so);
#pragma unroll
      for (int j = 0; j < 16; ++j) o[j] = (f32x4){S[2 * j].x, S[2 * j].y, S[2 * j + 1].x, S[2 * j + 1].y}; }
    __builtin_amdgcn_wave_barrier();
}
__device__ __forceinline__ void hgrn_sample_wave(const Args& a, int l, int task, MK_LDS float* wl  ) {
    const int lane = otid() & 63, seq = task / 12, rem = task % 12, head = rem >> 1, col = (rem & 1) * 64 + lane, row0 = NPR + seq * 8;
    const float* P = (const float*)(a.ws + WS_P); float* OHG = (float*)(a.ws + WS_OHG);
#pragma unroll
    for (int i = 0; i < 8; ++i) { const int e = lane + 64 * i, step = e >> 6, o4 = e & 63;
        const float* rp = P + (size_t)(row0 + step) * NIN + O_HG + head * 128;
        *(MK_LDS f32x4*)(wl + step * 320 + 4 * o4) = *(const f32x4*)(o4 < 32 ? rp + 4 * o4 : rp + 768 + 4 * (o4 - 32)); }
#pragma unroll
    for (int t = 0; t < 8; ++t) wl[t * 320 + 256 + lane] = P[(size_t)(row0 + t) * NIN + O_HG + 1536 + head * 128 + col];
    const size_t so = (size_t)((l * 128 + seq) * 6 + head) * 16384 + col;
    f32x2 S[64];
    { const float* s0 = inp(a, I_HGRN) + so;
#pragma unroll
      for (int k = 0; k < 64; ++k) { S[k].x = s0[(size_t)(2 * k) * 128]; S[k].y = s0[(size_t)(2 * k + 1) * 128]; } }
    __builtin_amdgcn_wave_barrier(); asm volatile("s_waitcnt lgkmcnt(0)" ::: "memory");
    for (int t = 0; t < 8; ++t) { const MK_LDS float* B = wl + t * 320;
        const float vv = B[256 + lane];
        const f32x2 vv2 = {vv, vv}; f32x2 oa = {0.f, 0.f}, ob = {0.f, 0.f};
#pragma unroll
        for (int j = 0; j < 32; ++j) { const f32x4 q4 = *(const MK_LDS f32x4*)(B + 4 * j), f4 = *(const MK_LDS f32x4*)(B + 128 + 4 * j);
            S[2 * j] = f4.xy * (S[2 * j] - vv2) + vv2; S[2 * j + 1] = f4.zw * (S[2 * j + 1] - vv2) + vv2;
            oa += q4.xy * S[2 * j]; ob += q4.zw * S[2 * j + 1]; }
        OHG[(size_t)(row0 + t) * 768 + head * 128 + col] = (oa.x + oa.y) + (ob.x + ob.y);
    }
    { float* o = a.out + O_HGRN_S + so;
#pragma unroll
      for (int k = 0; k < 64; ++k) { o[(size_t)(2 * k) * 128] = S[k].x; o[(size_t)(2 * k + 1) * 128] = S[k].y; } }
    __builtin_amdgcn_wave_barrier();
}

constexpr int Q_RWP = 48, Q_HGP = 192, Q_S5 = 1024, Q_SMP = 384, Q_TOTAL = Q_RWP + Q_HGP + Q_S5 + Q_SMP;
__device__ __forceinline__ void phase_scan(const Args& a, int l, MK_LDS unsigned char* lds, int qsel, int skip = 0) {
    const int tid = otid(), wave = tid >> 6;
    unsigned* qhead = (unsigned*)(a.ws + WS_CTL) + CW_Q + 64 * (l + qsel);
    volatile MK_LDS unsigned* qw = (volatile MK_LDS unsigned*)(lds + MISC_OFF + 16);
    const float* P = (const float*)(a.ws + WS_P); const float* RWB = (const float*)(a.ws + WS_RW);
    float* YRW = (float*)(a.ws + WS_YRW); float* OHG = (float*)(a.ws + WS_OHG);
    unsigned nxt = 0u; if (tid == 0) nxt = __hip_atomic_fetch_add(qhead, 1u, __ATOMIC_RELAXED, __HIP_MEMORY_SCOPE_AGENT);
    for (;;) {
        __syncthreads();
        if (tid == 0) qw[0] = nxt;
        __syncthreads();
        int t = (int)qw[0];
        if (t >= Q_TOTAL) break;
        if (tid == 0) nxt = __hip_atomic_fetch_add(qhead, 1u, __ATOMIC_RELAXED, __HIP_MEMORY_SCOPE_AGENT);
        if (t < Q_RWP) { if (!(skip & 1)) rwkv_chunk_b(a, l, t / 12, t % 12, lds); continue; }
        t -= Q_RWP;
        if (t < Q_HGP) { if (!(skip & 2)) hgrn_chunk_b(a, l, t / 48, (t / 8) % 6, t & 7); continue; }
        t -= Q_HGP;
        if (t < Q_S5) { if (!(skip & 4)) s5c_wave(a, l, t * 8 + wave, lds + wave * S5_WAVE_LDS); continue; }
        t -= Q_S5;
        if (!(skip & 8)) { const int wt = t * 8 + wave; if (wt < 1536) rwkv_sample_wave(a, l, wt, (MK_LDS float*)(lds + wave * 14464)); else hgrn_sample_wave(a, l, wt - 1536, (MK_LDS float*)(lds + wave * 14464)); }
    }
    conv_work(a, l + 1, -1, lds);
}
constexpr int Q1_PREP = 96, Q1_RWA = 1536, Q1_HGA = 768, Q1_S5A = 512, Q1_TOTAL = Q1_PREP + Q1_RWA + Q1_HGA + Q1_S5A;
__device__ __forceinline__ void phase_m1(const Args& a, int l, MK_LDS unsigned char* lds) {
    const int tid = otid(), wave = tid >> 6;
    unsigned* qhead = (unsigned*)(a.ws + WS_CTL) + CW_Q + 64 * (l + 8);
    volatile MK_LDS unsigned* qw = (volatile MK_LDS unsigned*)(lds + MISC_OFF + 16);
    unsigned nxt = 0u; if (tid == 0) nxt = __hip_atomic_fetch_add(qhead, 1u, __ATOMIC_RELAXED, __HIP_MEMORY_SCOPE_AGENT);
    for (;;) {
        __syncthreads();
        if (tid == 0) qw[0] = nxt;
        __syncthreads();
        int t = (int)qw[0];
        if (t >= Q1_TOTAL) break;
        if (tid == 0) nxt = __hip_atomic_fetch_add(qhead, 1u, __ATOMIC_RELAXED, __HIP_MEMORY_SCOPE_AGENT);
        if (t < Q1_PREP) { rwkv_prep(a, l, lds, 768 + t, 769 + t); continue; }
        t -= Q1_PREP;
        if (t < Q1_RWA) { rwkv_chunk_a(a, l, t / 384, (t / 32) % 12, t & 31, lds); continue; }
        t -= Q1_RWA;
        if (t < Q1_HGA) { hgrn_chunk_a(a, l, t / 192, (t / 32) % 6, t & 31, lds); continue; }
        t -= Q1_HGA;
        s5a_wave(a, l, t * 8 + wave, lds + wave * S5_WAVE_LDS);
    }
    __syncthreads();
    hgrn_prep(a, l);
}
__device__ __forceinline__ void phase_post(const Args& a, int l) {
    const int tid = otid(), lane = tid & 63, gw = blockIdx.x * 8 + (tid >> 6), nw = gridDim.x * 8;
    const float* P = (const float*)(a.ws + WS_P); const float* RWB = (const float*)(a.ws + WS_RW); const float* BON = (const float*)(a.ws + WS_BONUS);
    const float* YRW = (const float*)(a.ws + WS_YRW); const float* OHG = (const float*)(a.ws + WS_OHG); bf16_t* MIX = (bf16_t*)(a.ws + WS_MIX);
    const float* lnw = inp(a, I_LNW) + l * 768; const float* lnb = inp(a, I_LNB) + l * 768; const float* hnw = inp(a, I_HNW) + l * 768;
    for (int wt = gw; wt < 1024 * 6; wt += nw) { const int row = NPR + wt / 6, head = wt % 6, C = head * 128 + 2 * lane;
        const float2 o = *(const float2*)(OHG + (size_t)row * 768 + C); const float ms = wave_sum(o.x * o.x + o.y * o.y) * (1.0f / 128.0f); const float rs = rsqrtf(ms + 1e-5f);
        const float2 g = *(const float2*)(P + (size_t)row * NIN + O_HG + 2304 + C); const float2 w = *(const float2*)(hnw + C);
        *(unsigned*)(MIX + (size_t)row * D + 1280 + C) = cvt_pk_bf16(o.x * rs * w.x * silu_f(g.x), o.y * rs * w.y * silu_f(g.y)); }
    for (int i = blockIdx.x * 512 + tid; i < 132 * RSW; i += gridDim.x * 512) { const int s = i / RSW, c = i % RSW;
        if (s < 4) a.out[O_SHIFT_P + (size_t)(l * 4 + s) * RSW + c] = pbf((const bf16_t*)P + (size_t)(s * TP + TP - 1) * NIN + O_RW + c);
        else a.out[O_SHIFT_S + (size_t)(l * 128 + (s - 4)) * RSW + c] = P[(size_t)(NPR + (s - 4) * 8 + 7) * NIN + O_RW + c]; }
}
}

using mk::Args;
constexpr int N_PHASES = 1 + mk::NL * 12 + 1;
#ifndef MK_SITES
#define MK_SITES 0xFFFF
#endif
#define SITE(n) ((MK_SITES >> (n)) & 1)
#ifndef MK_REP
#define MK_REP 0
#endif
#define REP(n) ((MK_REP >> (n)) & 1)
__global__ void __launch_bounds__(512, 2) mk_fwd(Args a) {
    extern __shared__ __attribute__((aligned(16))) unsigned char lds_raw[];
    using namespace mk;
    MK_LDS unsigned char* lds = (MK_LDS unsigned char*)lds_raw;
    const int tid = threadIdx.x, G = gridDim.x;
#if MK_NANFILL
    for (int i = tid; i < LDS_BYTES / 4; i += 512) ((MK_LDS unsigned*)lds)[i] = 0u;
    __syncthreads();
#endif
    if (tid < 8) ((MK_LDS unsigned*)(lds + MISC_OFF))[tid] = 0u;
    __syncthreads();
    unsigned* ctl = (unsigned*)(a.ws + WS_CTL);
    XcdBarrier bar; bar.bar = ctl + CW_BAR; bar.x = 0; bar.st = (volatile LAS unsigned*)(lds + MISC_OFF);
#if !MK_PER_PHASE
    bar = xcd_barrier_post(ctl + CW_BAR, (volatile LAS unsigned*)(lds + MISC_OFF));
#endif
    for (int s = 0; s < 5; ++s) {
        const int Ns = s == 0 ? NGU : s == 1 ? D : s == 2 ? NIN : s == 3 ? 512 : D, Ks = s == 0 ? D : s == 1 ? DFF : s == 2 ? D : s == 3 ? 512 : D, km = s == 0 ? 5 : s == 1 ? 8 : s == 2 ? 2 : s == 3 ? 0 : 4;
        (void)pg8::fill_unit_table(NTOK, Ns, Ks, G, (int)blockIdx.x, km, (MK_LDS int*)(lds + MISC_OFF + 64 + s * 512), otid()); }
    const int lo = a.ph_lo, hi = a.ph_hi;
#define IN(k) (lo <= (k) && (k) < hi)
#if MK_PER_PHASE
#define SEAM(k) do { } while (0)
#else
#define SEAM(k) do { if ((k) + 1 < hi) xcd_barrier(bar); } while (0)
#endif
#define X ((bf16_t*)(a.ws + WS_X))
#define HB ((bf16_t*)(a.ws + WS_HB))
#define RSTD ((float*)(a.ws + WS_HB))
#define H ((bf16_t*)(a.ws + WS_H))
#define P ((float*)(a.ws + WS_P))
#define MIX ((bf16_t*)(a.ws + WS_MIX))
#define SKCTX(seq) pg8::SplitCtx{(float*)(a.ws + WS_SK) + (size_t)((seq) & 1) * 256 * 65536, (unsigned*)(a.ws + WS_SKC) + (size_t)(seq) * 96 * 16, (unsigned*)(a.ws + WS_CTL) + 128}
    int ph = 0;
    if (SITE(0) && IN(ph)) { phase_prologue(a, (MK_LDS float*)lds); if (REP(0)) { xcd_barrier(bar); phase_prologue(a, (MK_LDS float*)lds); } SEAM(ph); }
    ++ph;
    for (int l = 0; l < NL; ++l) {
        unsigned char* wl = a.ws + WS_W + (size_t)l * W_LAYER;
        for (int half = 0; half < 2; ++half) {
            if (SITE(1) && IN(ph) && (l | half) != 0) { phase_rstd(X, RSTD); SEAM(ph); }
            ++ph;
            if (SITE(2) && IN(ph)) { pg8::Gemm g{X, (const bf16_t*)(wl + (half ? W_GU2 : W_GU1)), NTOK, NGU, D}; pg8::TabOrder TS; TS.tab = (const MK_LDS int*)(lds + MISC_OFF + 64 + 0 * 512); EpiSwiGLU E{H, RSTD, stage_rstd(TS.tab, RSTD, lds)}; pg8::gemm_phase<EpiSwiGLU, pg8::TabOrder, true, true>(lds, g, TS, E, SKCTX(l * 6 + half * 3 + 0)); if ((int)blockIdx.x >= 5 * ((36 * 44) % G)) conv_work(a, l + 1 + half, 2, lds); SEAM(ph); }
            ++ph;
            if (SITE(3) && IN(ph)) { pg8::Gemm g{H, (const bf16_t*)(wl + (half ? W_DN2 : W_DN1)), NTOK, D, DFF}; EpiResid E{X, 0.5f}; pg8::TabOrder TS; TS.tab = (const MK_LDS int*)(lds + MISC_OFF + 64 + 1 * 512); pg8::gemm_phase<EpiResid, pg8::TabOrder, true, true>(lds, g, TS, E, SKCTX(l * 6 + half * 3 + 1)); if (REP(3)) { xcd_barrier(bar); EpiResid E0{X, 0.0f}; pg8::gemm_phase<EpiResid, pg8::TabOrder, true, true>(lds, g, TS, E0, SKCTX(24 + l * 6 + half * 3 + 1)); } SEAM(ph); }
            ++ph;
            if (half == 0) {
                if (SITE(4) && IN(ph)) { phase_rstd(X, RSTD); SEAM(ph); }
                ++ph;
                if (SITE(5) && IN(ph)) { pg8::Gemm g{X, (const bf16_t*)(wl + W_WIN), NTOK, NIN, D}; pg8::TabOrder TS; TS.tab = (const MK_LDS int*)(lds + MISC_OFF + 64 + 2 * 512); EpiStoreP E{P, NIN, RSTD, stage_rstd(TS.tab, RSTD, lds)}; pg8::gemm_phase<EpiStoreP, pg8::TabOrder, true, true>(lds, g, TS, E, SKCTX(l * 6 + 2)); if ((int)blockIdx.x >= 2 * ((36 * 24) % G)) conv_work(a, l + 1, 2, lds); SEAM(ph); }
                ++ph;
                if (SITE(6) && IN(ph)) { phase_m1(a, l, lds); SEAM(ph); }
                ++ph;
                if (SITE(7) && IN(ph)) { phase_scan(a, l, lds, 0); if (REP(7)) { xcd_barrier(bar); phase_scan(a, l, lds, 4, MK_QSKIP); } SEAM(ph); }
                ++ph;
                if (SITE(8) && IN(ph)) {
                    pg8::Gemm g{(const bf16_t*)(a.ws + WS_YS5B), (const bf16_t*)(wl + W_GLU), NTOK, 512, 512}; EpiGLU E{(const bf16_t*)(a.ws + WS_YS5B), inp(a, I_BGLU) + l * 512, MIX}; pg8::TabOrder TS; TS.tab = (const MK_LDS int*)(lds + MISC_OFF + 64 + 3 * 512); pg8::gemm_phase<EpiGLU, pg8::TabOrder, true, true>(lds, g, TS, E);
                    for (int rep = 0; rep < 1 + REP(8); ++rep) {
                    __syncthreads();
                    for (int task = blockIdx.x; task < 768; task += G) hgrn_chunk_c(a, l, task / 192, (task / 32) % 6, task & 31, lds);
                    for (int wt = blockIdx.x * 8 + (otid() >> 6); wt < 6144; wt += G * 8) rwkv_chunk_c_wave(a, l, wt);
                    phase_post(a, l);
                    }
                    SEAM(ph); }
                ++ph;
                if (SITE(9) && IN(ph)) { pg8::Gemm g{MIX, (const bf16_t*)(wl + W_WOUT), NTOK, D, D}; EpiResid E{X, 1.0f}; pg8::TabOrder TS; TS.tab = (const MK_LDS int*)(lds + MISC_OFF + 64 + 4 * 512); pg8::gemm_phase<EpiResid, pg8::TabOrder, true, true>(lds, g, TS, E, SKCTX(l * 6 + 5)); if ((int)blockIdx.x >= 4 * ((36 * 8) % G)) conv_work(a, l + 2, 2, lds); SEAM(ph); }
                ++ph;
            }
        }
    }
    if (SITE(10) && IN(ph)) phase_rmsnorm(X, inp(a, I_NORMF), nullptr, a.out + O_YP);
#undef IN
#undef SEAM
#undef X
#undef HB
#undef H
#undef P
#undef MIX
}

extern "C" void kernel_launch(void* const* d_in, const int* in_sizes, int n_in, void* d_out, int out_size, void* d_ws, size_t ws_size, hipStream_t stream) {
    using namespace mk;
    static int grid = 0;
    if (grid == 0) {
        if (n_in != N_IN || (size_t)out_size != O_END || ws_size < WS_END) { fprintf(stderr, "kernel_launch: unexpected shapes: n_in %d out %d ws %zu (need %zu)\n", n_in, out_size, ws_size, (size_t)WS_END); grid = -1; return; }
        int dev = 0, cus = 0, per_cu = 0;
        if (hipGetDevice(&dev) != hipSuccess || hipDeviceGetAttribute(&cus, hipDeviceAttributeMultiprocessorCount, dev) != hipSuccess) { grid = -1; return; }
        if (hipFuncSetAttribute((const void*)mk_fwd, hipFuncAttributeMaxDynamicSharedMemorySize, LDS_BYTES) != hipSuccess) { fprintf(stderr, "kernel_launch: hipFuncSetAttribute failed\n"); grid = -1; return; }
        if (hipOccupancyMaxActiveBlocksPerMultiprocessor(&per_cu, (const void*)mk_fwd, 512, LDS_BYTES) != hipSuccess || per_cu < 1) { fprintf(stderr, "kernel_launch: occupancy query says %d\n", per_cu); (void)hipGetLastError(); }
        grid = cus;
    }
    if (grid < 0) return;
    (void)in_sizes;
    if (hipMemsetAsync((char*)d_ws + WS_CTL, 0, CTL_BYTES, stream) != hipSuccess) return;
    if (hipMemsetAsync((char*)d_ws + WS_SKC, 0, SKC_BYTES, stream) != hipSuccess) return;
#if MK_NANFILL
    (void)hipMemsetAsync((char*)d_ws + WS_X, 0x00, WS_W - WS_X, stream);
#endif
    Args a{};
    for (int i = 0; i < N_IN; ++i) a.in[i] = (const float*)d_in[i];
    a.out = (float*)d_out; a.ws = (unsigned char*)d_ws;
#if MK_PER_PHASE
    for (int p = 0; p < N_PHASES; ++p) { a.ph_lo = p; a.ph_hi = p + 1; hipLaunchKernelGGL(mk_fwd, dim3(grid), dim3(512), LDS_BYTES, stream, a); }
#else
    a.ph_lo = 0; a.ph_hi = N_PHASES; hipLaunchKernelGGL(mk_fwd, dim3(grid), dim3(512), LDS_BYTES, stream, a);
#endif
    const hipError_t le = hipPeekAtLastError();
    if (le != hipSuccess) fprintf(stderr, "kernel_launch: launch failed: %s\n", hipGetErrorName(le));
}
```
